# Optimizing an MI355X kernel written in HIP

```python
import jax, jax.numpy as jnp
from jax import lax
import numpy as np

D_MODEL = 1024
BATCH = 2
SEQ = 8192
DEPTH = 4

CTX_LEN = 256
GRID_W = 64
HGRN_HEADS = 8
HGRN_HEAD_DIM = D_MODEL // HGRN_HEADS
CHUNK = 64
CONV_WIDTH = 3
FFN_HIDDEN = ((8 * D_MODEL + 3 * 256 - 1) // (3 * 256)) * 256
N_HGRN_LAYERS = (DEPTH + 1) // 2
N_CONV_LAYERS = DEPTH // 2
N_MOD = 6
EPS = 1e-6
F_FLOOR = 1e-6

kernel_name = "hybrid_hgrn2_shortconv_dit_trunk"


def _rmsnorm(x, w):
    xf = x.astype(jnp.float32)
    y = xf * lax.rsqrt(jnp.mean(xf * xf, axis=-1, keepdims=True) + EPS)
    return (y * w.astype(jnp.float32)).astype(x.dtype)


def _modulate(h, shift, scale):
    return h * (1 + scale) + shift


def _heads(t):
    return t.reshape(t.shape[:-1] + (HGRN_HEADS, HGRN_HEAD_DIM))


def _chunk_scan(q, k, v, log_f, s0):
    b, l, h, _ = q.shape
    dv = v.shape[-1]
    n = l // CHUNK

    def to_chunks(t):
        return t.astype(jnp.float32).reshape(b, n, CHUNK, h, t.shape[-1]).transpose(1, 0, 3, 2, 4)

    mask = jnp.tril(jnp.ones((CHUNK, CHUNK), dtype=bool))[:, :, None]

    def step(s, inp):
        qc, kc, vc, gc = inp
        cum = jnp.cumsum(gc, axis=2)
        o_inter = jnp.einsum("bhtk,bhkv->bhtv", qc * jnp.exp(cum), s)
        diff = cum[:, :, :, None, :] - cum[:, :, None, :, :]
        decay = jnp.where(mask, jnp.exp(jnp.where(mask, diff, 0.0)), 0.0)
        scores = jnp.einsum("bhtk,bhsk,bhtsk->bhts", qc, kc, decay)
        o = o_inter + jnp.einsum("bhts,bhsv->bhtv", scores, vc)
        last = cum[:, :, -1:, :]
        s_new = jnp.exp(last[:, :, 0, :])[..., None] * s + jnp.einsum(
            "bhsk,bhsv->bhkv", kc * jnp.exp(last - cum), vc)
        return s_new, o

    s_fin, o = lax.scan(step, s0, (to_chunks(q), to_chunks(k), to_chunks(v), to_chunks(log_f)))
    return o.transpose(1, 0, 3, 2, 4).reshape(b, l, h, dv), s_fin


def _forget_gates(z, lb):
    zf = z.astype(jnp.float32)
    f = lb + (1.0 - lb) * jax.nn.sigmoid(zf)
    log_f = jnp.log(jnp.maximum(f, F_FLOOR))
    k = (1.0 - lb) * jax.nn.sigmoid(-zf)
    return _heads(k), _heads(log_f)


def _direction(qc, vc, zc, ql, vl, zl, lb, s0):
    kc, lc = _forget_gates(zc, lb)
    kl, ll = _forget_gates(zl, lb)
    oc, s_ctx = _chunk_scan(qc, kc, vc, lc, s0)
    ol, _ = _chunk_scan(ql, kl, vl, ll, s_ctx)
    return oc, ol


def _readout(o, g, g_norm, w_out, dtype):
    o = o * lax.rsqrt(jnp.mean(o * o, axis=-1, keepdims=True) + EPS) * g_norm.astype(jnp.float32)
    o = o * jax.nn.silu(_heads(g.astype(jnp.float32)))
    return o.reshape(o.shape[:-2] + (HGRN_HEADS * HGRN_HEAD_DIM,)).astype(dtype) @ w_out


def _hgrn2_mixer(h, hc, w_in, w_out, g_norm, lb, need_ctx_out):
    lb = lb.astype(jnp.float32)
    q_scale = HGRN_HEAD_DIM ** -0.5
    ql, vl, zfl, zbl, gl = jnp.split(h @ w_in, 5, axis=-1)
    qc, vc, zfc, zbc, gc = jnp.split(hc @ w_in, 5, axis=-1)
    ql, qc = _heads(ql) * q_scale, _heads(qc) * q_scale
    vl, vc = _heads(vl), _heads(vc)
    s0 = jnp.zeros((h.shape[0], HGRN_HEADS, HGRN_HEAD_DIM, HGRN_HEAD_DIM), jnp.float32)

    def flip(t):
        return jnp.flip(t, axis=1)

    oc_f, ol_f = _direction(qc, vc, zfc, ql, vl, zfl, lb, s0)
    oc_b, ol_b = _direction(flip(qc), flip(vc), flip(zbc), flip(ql), flip(vl), flip(zbl), lb, s0)
    y = _readout(ol_f + flip(ol_b), gl, g_norm, w_out, h.dtype)
    yc = _readout(oc_f + flip(oc_b), gc, g_norm, w_out, hc.dtype) if need_ctx_out else None
    return y, yc


def _dwconv(u, w):
    pad = CONV_WIDTH // 2
    length = u.shape[1]
    up = jnp.pad(u, ((0, 0), (pad, CONV_WIDTH - 1 - pad), (0, 0)))
    out = up[:, 0:length] * w[0]
    for j in range(1, CONV_WIDTH):
        out = out + up[:, j:j + length] * w[j]
    return out


def _short_conv_mixer(h, w_in, w_conv, w_out, rows):
    b, l, d = h.shape
    gate_b, gate_c, xin = jnp.split(h @ w_in, 3, axis=-1)
    u = gate_c * xin
    if rows is None:
        y = _dwconv(u, w_conv)
    else:
        y = _dwconv(u.reshape(b * rows, GRID_W, d), w_conv).reshape(b, l, d)
    return (gate_b * y) @ w_out


def _swiglu(h, w_in, w_out):
    gate, up = jnp.split(h @ w_in, 2, axis=-1)
    return (jax.nn.silu(gate) * up) @ w_out


def setup_inputs(seed: int = 0) -> dict:
    key = jax.random.key(seed)
    ks = jax.random.split(key, 16)
    d = D_MODEL

    def nrm(k, shape, scale):
        return scale * jax.random.normal(k, shape, jnp.float32)

    return {
        "x": nrm(ks[0], (BATCH, SEQ, d), 1.0),
        "c": nrm(ks[1], (BATCH, d), 1.0),
        "ctx": nrm(ks[2], (BATCH, CTX_LEN, d), 1.0),
        "c_ctx": nrm(ks[3], (d,), 1.0),
        "ada_w": nrm(ks[4], (DEPTH, d, N_MOD * d), 0.5 * d ** -0.5),
        "ada_b": nrm(ks[5], (DEPTH, N_MOD * d), 0.01),
        "norm_w": 1.0 + nrm(ks[6], (DEPTH, 4, d), 0.05),
        "hgrn_w_in": nrm(ks[7], (N_HGRN_LAYERS, d, 5 * d), d ** -0.5),
        "hgrn_w_out": nrm(ks[8], (N_HGRN_LAYERS, d, d), d ** -0.5),
        "hgrn_gnorm": 1.0 + nrm(ks[9], (N_HGRN_LAYERS, HGRN_HEAD_DIM), 0.05),
        "hgrn_lb": 1.0 + nrm(ks[10], (N_HGRN_LAYERS, HGRN_HEADS * HGRN_HEAD_DIM), 0.5),
        "conv_w_in": nrm(ks[11], (N_CONV_LAYERS, d, 3 * d), d ** -0.5),
        "conv_w": nrm(ks[12], (N_CONV_LAYERS, CONV_WIDTH, d), CONV_WIDTH ** -0.5),
        "conv_w_out": nrm(ks[13], (N_CONV_LAYERS, d, d), d ** -0.5),
        "ffn_w_in": nrm(ks[14], (DEPTH, d, 2 * FFN_HIDDEN), d ** -0.5),
        "ffn_w_out": nrm(ks[15], (DEPTH, FFN_HIDDEN, d), FFN_HIDDEN ** -0.5),
    }


def reference(x, c, ctx, c_ctx, ada_w, ada_b, norm_w, hgrn_w_in, hgrn_w_out, hgrn_gnorm, hgrn_lb,
              conv_w_in, conv_w, conv_w_out, ffn_w_in, ffn_w_out):
    rows = x.shape[1] // GRID_W
    soft = jax.nn.softmax(hgrn_lb.astype(jnp.float32), axis=0)
    lower_bounds = jnp.cumsum(soft, axis=0) - soft[0]
    silu_c = jax.nn.silu(c)
    silu_cc = jax.nn.silu(c_ctx)
    for l in range(DEPTH):
        j = l // 2
        is_hgrn = l % 2 == 0
        need_ctx_out = l < DEPTH - 1
        mod = silu_c @ ada_w[l] + ada_b[l]
        sh1, sc1, g1, sh2, sc2, g2 = [m[:, None, :] for m in jnp.split(mod, N_MOD, axis=-1)]
        h = _modulate(_rmsnorm(x, norm_w[l, 0]), sh1, sc1)
        if is_hgrn or need_ctx_out:
            cmod = silu_cc @ ada_w[l] + ada_b[l]
            csh1, csc1, cg1, csh2, csc2, cg2 = jnp.split(cmod, N_MOD, axis=-1)
            hc = _modulate(_rmsnorm(ctx, norm_w[l, 0]), csh1, csc1)
        if is_hgrn:
            y, yc = _hgrn2_mixer(h, hc, hgrn_w_in[j], hgrn_w_out[j], hgrn_gnorm[j],
                                 lower_bounds[j], need_ctx_out)
        else:
            y = _short_conv_mixer(h, conv_w_in[j], conv_w[j], conv_w_out[j], rows)
            yc = _short_conv_mixer(hc, conv_w_in[j], conv_w[j], conv_w_out[j], None) if need_ctx_out else None
        x = x + g1 * _rmsnorm(y, norm_w[l, 1])
        hf = _modulate(_rmsnorm(x, norm_w[l, 2]), sh2, sc2)
        x = x + g2 * _rmsnorm(_swiglu(hf, ffn_w_in[l], ffn_w_out[l]), norm_w[l, 3])
        if need_ctx_out:
            ctx = ctx + cg1 * _rmsnorm(yc, norm_w[l, 1])
            hfc = _modulate(_rmsnorm(ctx, norm_w[l, 2]), csh2, csc2)
            ctx = ctx + cg2 * _rmsnorm(_swiglu(hfc, ffn_w_in[l], ffn_w_out[l]), norm_w[l, 3])
    return x
```

```cpp
#include <hip/hip_runtime.h>
#include <hip/hip_cooperative_groups.h>
#include <cstdio>
#include <cstdint>
namespace cg = cooperative_groups;
namespace pg8 {
#define PG8_LAS __attribute__((address_space(3)))
typedef unsigned short bf16_t;
typedef short bf16x8 __attribute__((ext_vector_type(8)));
typedef float f32x4 __attribute__((ext_vector_type(4)));
typedef unsigned u32x4 __attribute__((ext_vector_type(4)));
constexpr int BM = 256, BK = 64, HALF = 128, HTB = HALF * BK * 2  , STAGE_BYTES = 8 * HTB, NXCD = 8, WGM = 8;

__host__ __device__ __forceinline__ int lds_byte(int r, int c) { const int st = (r >> 4) * 2 + (c >> 5), rr = r & 15, cc = c & 31, ob = rr * 64 + cc * 2; return st * 1024 + (ob ^ (((ob >> 9) & 1) << 5)); }
__host__ __device__ __forceinline__ void stage_rc(int b, int& R, int& C) { const int st = b / 1024, sb = b % 1024, swz = sb ^ (((sb >> 9) & 1) << 5); R = (st >> 1) * 16 + swz / 64; C = (st & 1) * 32 + (swz % 64) / 2; }
__host__ __device__ __forceinline__ int perm32(int rho) { const int n = rho >> 4, i = rho & 15; return 8 * (i >> 2) + 4 * n + (i & 3); }

struct Unit { int pm, pn; };
struct Gemm { const bf16_t* A; const bf16_t* Bt; int M, N, K; };

struct StaticOrder {
    int nM, nN, nwg, G, c;
    __host__ __device__ void init(int M, int N, int G_, int c_) { nM = M / BM; nN = N / BM; nwg = nM * nN; G = G_; c = c_; }
    __host__ __device__ bool next(int i, Unit& u) const {
        const long L = (long)i * G + c; if (L >= nwg) return false;
        int wgid = (int)L; { const int q = nwg / NXCD, r = nwg % NXCD, xcd = wgid % NXCD, off = wgid / NXCD; wgid = (xcd < r ? xcd * (q + 1) : r * (q + 1) + (xcd - r) * q) + off; }
        const int nig = WGM * nN, gid = wgid / nig, fm = gid * WGM, gsz = (nM - fm) < WGM ? (nM - fm) : WGM;
        u.pm = fm + ((wgid % nig) % gsz); u.pn = (wgid % nig) / gsz; return true;
    }
    __device__ __forceinline__ void a_ready(const Unit&) const {}
    __device__ __forceinline__ void done(const Unit&) const {}
};

__device__ __forceinline__ unsigned cvt_pk_bf16(float lo, float hi) { unsigned r; asm volatile("v_cvt_pk_bf16_f32 %0, %1, %2" : "=v"(r) : "v"(lo), "v"(hi)); return r; }
typedef float f32x2 __attribute__((ext_vector_type(2)));
__device__ __forceinline__ void st16_wt(void* p, u32x4 v) { asm volatile("global_store_dwordx4 %0, %1, off sc1\n\ts_nop 1" :: "v"(p), "v"(v) : "memory"); }
typedef unsigned u32x2_ __attribute__((ext_vector_type(2)));
__device__ __forceinline__ void st8_wt(void* p, u32x2_ v) { asm volatile("global_store_dwordx2 %0, %1, off sc1\n\ts_nop 1" :: "v"(p), "v"(v) : "memory"); }

template <class Epi, class Sched, bool ALIGN_EPI = false, bool SP2 = false>
__device__ __forceinline__ void gemm_phase(PG8_LAS unsigned char* lds, const Gemm g, const Sched& S, const Epi& E) {
    const int tid = threadIdx.x, wid = __builtin_amdgcn_readfirstlane(tid >> 6), lane = tid & 63, wr = wid >> 2, wc = wid & 3, fr = lane & 15, fq = lane >> 4;
    const int K = g.K, nt = K / BK;
    unsigned voffA[2], voffB[2];
#pragma unroll
    for (int i = 0; i < 2; ++i) { int R, C; stage_rc(tid * 16 + i * 8192, R, C); const int Rb = Epi::PERM ? ((R & ~31) + perm32(R & 31)) : R;
        voffA[i] = (unsigned)(R * K + C) * 2u; voffB[i] = (unsigned)(Rb * K + C) * 2u; }
    const size_t kstep = (size_t)(BK * 2);
    const size_t hstep = (size_t)HALF * K * 2;
    const size_t tstep = 2 * hstep;
    const unsigned ldsw = (unsigned)wid * 1024u;
    const int aoff = lds_byte(wr * 64 + fr, fq * 8), boff = lds_byte(wc * 32 + fr, fq * 8);
#define PG8_SA(b, h) (((b) * 2 + (h)) * HTB)
#define PG8_SB(b, h) ((4 + (b) * 2 + (h)) * HTB)
#define PG8_STAGE(bufoff, gbase, voff) do { _Pragma("unroll") for (int _i = 0; _i < 2; ++_i) \
        __builtin_amdgcn_global_load_lds((const unsigned*)((const char*)(gbase) + (voff)[_i]), (PG8_LAS unsigned*)(lds + (bufoff) + ldsw + _i * 8192), 16, 0, 0); } while (0)
#define PG8_LDA(dst, b, h) do { _Pragma("unroll") for (int m = 0; m < 4; ++m) _Pragma("unroll") for (int k = 0; k < 2; ++k) dst[m][k] = *(const PG8_LAS bf16x8*)(lds + PG8_SA(b, h) + aoff + m * 2048 + k * 1024); } while (0)
#define PG8_LDB(dst, b, h) do { _Pragma("unroll") for (int n = 0; n < 2; ++n) _Pragma("unroll") for (int k = 0; k < 2; ++k) dst[n][k] = *(const PG8_LAS bf16x8*)(lds + PG8_SB(b, h) + boff + n * 2048 + k * 1024); } while (0)
#define PG8_MMA(ai, bj, At, Bt) do { __builtin_amdgcn_s_setprio(1); _Pragma("unroll") for (int m = 0; m < 4; ++m) _Pragma("unroll") for (int n = 0; n < 2; ++n) _Pragma("unroll") for (int k = 0; k < 2; ++k) \
        acc[ai][bj][m][n] = __builtin_amdgcn_mfma_f32_16x16x32_bf16(Bt[n][k], At[m][k], acc[ai][bj][m][n], 0, 0, 0); __builtin_amdgcn_s_setprio(0); } while (0)
#define PG8_WAIT_V(n) asm volatile("s_waitcnt vmcnt(" #n ")" ::: "memory")
#define PG8_WAIT_L(n) asm volatile("s_waitcnt lgkmcnt(" #n ")" ::: "memory")
#define PG8_BAR __builtin_amdgcn_s_barrier()
#define PG8_SCHED __builtin_amdgcn_sched_barrier(0)
    Unit cur, nxt; int ui = 0;
    if (!S.next(0, cur)) return;
    f32x4 acc[2][2][4][2];
#pragma unroll
    for (int a = 0; a < 2; ++a)
#pragma unroll
        for (int b = 0; b < 2; ++b)
#pragma unroll
            for (int m = 0; m < 4; ++m)
#pragma unroll
                for (int n = 0; n < 2; ++n) acc[a][b][m][n] = (f32x4){0.f, 0.f, 0.f, 0.f};
    bf16x8 At[4][2], B0[2][2], B1[2][2];
    const char* cA = (const char*)g.A + (size_t)cur.pm * tstep; const char* cB = (const char*)g.Bt + (size_t)cur.pn * tstep;
    S.a_ready(cur);
    if constexpr (SP2) {
        PG8_STAGE(PG8_SB(0, 0), cB, voffB); PG8_STAGE(PG8_SB(0, 1), cB + hstep, voffB); PG8_STAGE(PG8_SA(0, 0), cA, voffA); PG8_STAGE(PG8_SA(0, 1), cA + hstep, voffA);
        if (wr == 1) PG8_BAR;
        PG8_WAIT_V(2); PG8_BAR;
        PG8_STAGE(PG8_SB(1, 0), cB + kstep, voffB); PG8_STAGE(PG8_SA(1, 0), cA + kstep, voffA); PG8_STAGE(PG8_SB(1, 1), cB + hstep + kstep, voffB);
        PG8_WAIT_V(6); PG8_BAR;
    } else {
        PG8_STAGE(PG8_SB(0, 0), cB, voffB); PG8_STAGE(PG8_SA(0, 0), cA, voffA); PG8_STAGE(PG8_SB(0, 1), cB + hstep, voffB); PG8_STAGE(PG8_SA(0, 1), cA + hstep, voffA);
        if (wr == 1) PG8_BAR;
        PG8_WAIT_V(4); PG8_BAR;
        PG8_STAGE(PG8_SB(1, 0), cB + kstep, voffB); PG8_STAGE(PG8_SA(1, 0), cA + kstep, voffA); PG8_STAGE(PG8_SB(1, 1), cB + hstep + kstep, voffB);
        PG8_WAIT_V(6); PG8_BAR;
    }
    for (;;) {
        const bool has_next = S.next(ui + 1, nxt);
        const char* nA = has_next ? (const char*)g.A + (size_t)nxt.pm * tstep : cA; const char* nB = has_next ? (const char*)g.Bt + (size_t)nxt.pn * tstep : cB;
        for (int t = 0; t < nt; t += 2) {
            const bool last = (t == nt - 2);
            const char* a1 = cA + (size_t)(t + 1) * kstep;
            const char* a2 = last ? nA : cA + (size_t)(t + 2) * kstep; const char* b2 = last ? nB : cB + (size_t)(t + 2) * kstep;
            const char* a3 = a2 + kstep; const char* b3 = b2 + kstep;
            if (last && has_next) S.a_ready(nxt);
            if constexpr (SP2) {
            PG8_LDB(B0, 0, 0); PG8_LDB(B1, 0, 1); PG8_SCHED; PG8_LDA(At, 0, 0); PG8_STAGE(PG8_SA(1, 1), a1 + hstep, voffA);
            PG8_WAIT_V(8); PG8_WAIT_L(0); PG8_BAR; PG8_MMA(0, 0, At, B0); PG8_MMA(0, 1, At, B1); PG8_BAR; PG8_SCHED;
            PG8_LDA(At, 0, 1); PG8_STAGE(PG8_SB(0, 0), b2, voffB); PG8_STAGE(PG8_SB(0, 1), b2 + hstep, voffB); PG8_STAGE(PG8_SA(0, 0), a2, voffA);
            PG8_WAIT_V(8); PG8_WAIT_L(0); PG8_BAR; PG8_MMA(1, 0, At, B0); PG8_MMA(1, 1, At, B1); PG8_BAR; PG8_SCHED;
            PG8_LDB(B0, 1, 0); PG8_LDB(B1, 1, 1); PG8_SCHED; PG8_LDA(At, 1, 0); PG8_STAGE(PG8_SA(0, 1), a2 + hstep, voffA);
            PG8_WAIT_V(8); PG8_WAIT_L(0); PG8_BAR; PG8_MMA(0, 0, At, B0); PG8_MMA(0, 1, At, B1); PG8_BAR; PG8_SCHED;
            PG8_LDA(At, 1, 1); PG8_STAGE(PG8_SB(1, 0), b3, voffB); PG8_STAGE(PG8_SB(1, 1), b3 + hstep, voffB); PG8_STAGE(PG8_SA(1, 0), a3, voffA);
            PG8_WAIT_V(8); PG8_WAIT_L(0); PG8_BAR; PG8_MMA(1, 0, At, B0); PG8_MMA(1, 1, At, B1); PG8_BAR; PG8_SCHED;
            } else {
            PG8_LDB(B0, 0, 0); PG8_SCHED; PG8_LDA(At, 0, 0); PG8_STAGE(PG8_SA(1, 1), a1 + hstep, voffA);
            PG8_WAIT_L(8); PG8_BAR; PG8_WAIT_L(0); PG8_MMA(0, 0, At, B0); PG8_BAR; PG8_SCHED;
            PG8_LDB(B1, 0, 1); PG8_STAGE(PG8_SB(0, 0), b2, voffB);
            PG8_BAR; PG8_WAIT_L(0); PG8_MMA(0, 1, At, B1); PG8_BAR;
            PG8_LDA(At, 0, 1); PG8_STAGE(PG8_SA(0, 0), a2, voffA);
            PG8_BAR; PG8_WAIT_L(0); PG8_MMA(1, 0, At, B0); PG8_BAR; PG8_SCHED;
            PG8_STAGE(PG8_SB(0, 1), b2 + hstep, voffB);
            PG8_WAIT_V(6); PG8_BAR; PG8_MMA(1, 1, At, B1); PG8_BAR;
            PG8_LDB(B0, 1, 0); PG8_SCHED; PG8_LDA(At, 1, 0); PG8_STAGE(PG8_SA(0, 1), a2 + hstep, voffA);
            PG8_WAIT_L(8); PG8_BAR; PG8_WAIT_L(0); PG8_MMA(0, 0, At, B0); PG8_BAR; PG8_SCHED;
            PG8_LDB(B1, 1, 1); PG8_STAGE(PG8_SB(1, 0), b3, voffB);
            PG8_BAR; PG8_WAIT_L(0); PG8_MMA(0, 1, At, B1); PG8_BAR;
            PG8_LDA(At, 1, 1); PG8_STAGE(PG8_SA(1, 0), a3, voffA);
            PG8_BAR; PG8_WAIT_L(0); PG8_MMA(1, 0, At, B0); PG8_BAR; PG8_SCHED;
            PG8_STAGE(PG8_SB(1, 1), b3 + hstep, voffB);
            PG8_WAIT_V(6); PG8_BAR; PG8_MMA(1, 1, At, B1); PG8_BAR;
            }
        }
        if constexpr (ALIGN_EPI) { if (wr == 0) PG8_BAR; }
        if constexpr (!Epi::AFTER_DRAIN) { E(acc, cur, wr, wc, fr, fq); S.done(cur); }
        if (!has_next) break;
#pragma unroll
        for (int a = 0; a < 2; ++a)
#pragma unroll
            for (int b = 0; b < 2; ++b)
#pragma unroll
                for (int m = 0; m < 4; ++m)
#pragma unroll
                    for (int n = 0; n < 2; ++n) acc[a][b][m][n] = (f32x4){0.f, 0.f, 0.f, 0.f};
        cur = nxt; cA = nA; cB = nB; ++ui;
        if constexpr (ALIGN_EPI) { if (wr == 1) PG8_BAR; }
    }
    PG8_WAIT_V(0);
    if constexpr (!ALIGN_EPI) { if (wr == 0) PG8_BAR; }
    PG8_BAR;
    if constexpr (Epi::AFTER_DRAIN) { E.fused(acc, cur, wr, wc, fr, fq, lds, wid, lane); S.done(cur); }
#undef PG8_SA
#undef PG8_SB
#undef PG8_STAGE
#undef PG8_LDA
#undef PG8_LDB
#undef PG8_MMA
#undef PG8_WAIT_V
#undef PG8_WAIT_L
#undef PG8_BAR
#undef PG8_SCHED
}
}
namespace pg8 {
struct EpiBf16 {
    static constexpr bool PERM = true, AFTER_DRAIN = false;
    bf16_t* O; int ldc;
    __device__ __forceinline__ void operator()(const f32x4 (&acc)[2][2][4][2], const Unit& u, int wr, int wc, int fr, int fq) const {
        const int row0 = u.pm * BM + wr * 64 + fr; const int col0 = u.pn * BM + wc * 32 + 8 * fq;
#pragma unroll
        for (int ai = 0; ai < 2; ++ai)
#pragma unroll
            for (int m = 0; m < 4; ++m) { bf16_t* rowp = O + (size_t)(row0 + ai * HALF + m * 16) * ldc + col0;
#pragma unroll
                for (int bj = 0; bj < 2; ++bj) { const f32x4 v0 = acc[ai][bj][m][0], v1 = acc[ai][bj][m][1];
                    u32x4 w; w.x = cvt_pk_bf16(v0[0], v0[1]); w.y = cvt_pk_bf16(v0[2], v0[3]); w.z = cvt_pk_bf16(v1[0], v1[1]); w.w = cvt_pk_bf16(v1[2], v1[3]);
                    *(u32x4*)(rowp + bj * HALF) = w; } }
    }
};
struct EpiSwiGLU {
    static constexpr bool PERM = true, AFTER_DRAIN = false;
    bf16_t* O; int ldc;
    __device__ __forceinline__ void operator()(const f32x4 (&acc)[2][2][4][2], const Unit& u, int wr, int wc, int fr, int fq) const {
        const int row0 = u.pm * BM + wr * 64 + fr; const int col0 = u.pn * HALF + wc * 32 + 8 * fq;
#pragma unroll
        for (int ai = 0; ai < 2; ++ai)
#pragma unroll
            for (int m = 0; m < 4; ++m) { bf16_t* rowp = O + (size_t)(row0 + ai * HALF + m * 16) * ldc + col0;
                float r[8];
#pragma unroll
                for (int n = 0; n < 2; ++n)
#pragma unroll
                    for (int i = 0; i < 4; ++i) { const float g = acc[ai][0][m][n][i], up = acc[ai][1][m][n][i]; r[4 * n + i] = g * __builtin_amdgcn_rcpf(1.f + __expf(-g)) * up; }
                u32x4 w; w.x = cvt_pk_bf16(r[0], r[1]); w.y = cvt_pk_bf16(r[2], r[3]); w.z = cvt_pk_bf16(r[4], r[5]); w.w = cvt_pk_bf16(r[6], r[7]);
                *(u32x4*)rowp = w; }
    }
};
struct EpiF32 {
    static constexpr bool PERM = false, AFTER_DRAIN = false;
    float* O; int ldc;
    __device__ __forceinline__ void operator()(const f32x4 (&acc)[2][2][4][2], const Unit& u, int wr, int wc, int fr, int fq) const {
        const int row0 = u.pm * BM + wr * 64 + fr; const int col0 = u.pn * BM + wc * 32 + 4 * fq;
#pragma unroll
        for (int ai = 0; ai < 2; ++ai)
#pragma unroll
            for (int m = 0; m < 4; ++m) { float* rowp = O + (size_t)(row0 + ai * HALF + m * 16) * ldc + col0;
#pragma unroll
                for (int bj = 0; bj < 2; ++bj)
#pragma unroll
                    for (int n = 0; n < 2; ++n) *(f32x4*)(rowp + bj * HALF + n * 16) = acc[ai][bj][m][n]; }
    }
};
}
#define LAS __attribute__((address_space(3)))
typedef unsigned short bf16;
typedef float f32x4 __attribute__((ext_vector_type(4)));
typedef float f32x16 __attribute__((ext_vector_type(16)));
typedef float f32x2 __attribute__((ext_vector_type(2)));
typedef short bf16x8 __attribute__((ext_vector_type(8)));
typedef unsigned u32x4 __attribute__((ext_vector_type(4)));
typedef unsigned u32x2 __attribute__((ext_vector_type(2)));
constexpr int D = 1024, NB = 2, SEQ = 8192, CTXL = 256, ML = NB * SEQ, MC = NB * CTXL, MALL = ML + MC, FF = 2816, NH = 8, HD = 128;
constexpr int NCH = 132;
constexpr float EPS = 1e-6f, F_FLOOR = 1e-6f;
constexpr int NWAVES = 8, NT = 512;
constexpr int LDS_BYTES = 147456;
constexpr size_t MiB = 1u << 20;
constexpr size_t WS_BAR = 0;
constexpr size_t WS_MOD = 65536;
constexpr size_t CTL_ZERO_BYTES = 1 * MiB;
constexpr size_t WS_WMI = 1 * MiB, WS_WMO = 11 * MiB, WS_WF1 = 13 * MiB, WS_WF2 = 24 * MiB;
constexpr size_t WS_XC = 30 * MiB;
constexpr size_t WS_H = 32 * MiB;
constexpr size_t WS_P = 65 * MiB;
constexpr size_t WS_Y1 = WS_P, WS_A = WS_P, WS_Y2 = WS_P + 91 * MiB;
constexpr size_t WS_S = 230 * MiB;
constexpr size_t WS_DEC = 362 * MiB;
constexpr size_t WS_END = 367 * MiB;

__device__ __forceinline__ unsigned f2bf(float f) { unsigned u = __builtin_bit_cast(unsigned, f); return (u + 0x7fffu + ((u >> 16) & 1u)) >> 16; }
__device__ __forceinline__ unsigned pk2(float lo, float hi) { return f2bf(lo) | (f2bf(hi) << 16); }
__device__ __forceinline__ unsigned cvtpk(float lo, float hi) { unsigned r; asm("v_cvt_pk_bf16_f32 %0, %1, %2" : "=v"(r) : "v"(lo), "v"(hi)); return r; }
__device__ __forceinline__ float bf2f(unsigned short u) { return __builtin_bit_cast(float, (unsigned)u << 16); }
__device__ __forceinline__ float bflo(unsigned w) { return __builtin_bit_cast(float, w << 16); }
__device__ __forceinline__ float bfhi(unsigned w) { return __builtin_bit_cast(float, w & 0xffff0000u); }
__device__ __forceinline__ float dpp_xor1(float v) { return __builtin_bit_cast(float, __builtin_amdgcn_update_dpp(0, __builtin_bit_cast(int, v), 0xB1, 0xF, 0xF, true)); }
__device__ __forceinline__ float dpp_xor2(float v) { return __builtin_bit_cast(float, __builtin_amdgcn_update_dpp(0, __builtin_bit_cast(int, v), 0x4E, 0xF, 0xF, true)); }
__device__ __forceinline__ float dpp_hmir(float v) { return __builtin_bit_cast(float, __builtin_amdgcn_update_dpp(0, __builtin_bit_cast(int, v), 0x141, 0xF, 0xF, true)); }
__device__ __forceinline__ float dpp_rmir(float v) { return __builtin_bit_cast(float, __builtin_amdgcn_update_dpp(0, __builtin_bit_cast(int, v), 0x140, 0xF, 0xF, true)); }
__device__ __forceinline__ float wave_sum(float v) {
    v += dpp_xor1(v); v += dpp_xor2(v); v += dpp_hmir(v); v += dpp_rmir(v);
    const int iv = __builtin_bit_cast(int, v);
    const float r0 = __builtin_bit_cast(float, __builtin_amdgcn_readlane(iv, 0)), r1 = __builtin_bit_cast(float, __builtin_amdgcn_readlane(iv, 16));
    const float r2 = __builtin_bit_cast(float, __builtin_amdgcn_readlane(iv, 32)), r3 = __builtin_bit_cast(float, __builtin_amdgcn_readlane(iv, 48));
    return (r0 + r1) + (r2 + r3);
}
__device__ __forceinline__ float sigmoidf_(float z) { return __builtin_amdgcn_rcpf(1.f + __expf(-z)); }

#define MFMA32(a, b, c) __builtin_amdgcn_mfma_f32_32x32x16_bf16((a), (b), (c), 0, 0, 0)
__device__ __forceinline__ int crow(int i, int hh) { return (i & 3) + 8 * (i >> 2) + 4 * hh; }
struct Args { const float* in[16]; float* out; unsigned char* ws; };
enum { I_X = 0, I_C, I_CTX, I_CCTX, I_ADAW, I_ADAB, I_NORMW, I_HWIN, I_HWOUT, I_HGN, I_HLB, I_CWIN, I_CW, I_CWOUT, I_FWIN, I_FWOUT };

__device__ __forceinline__ void transpose_item(const float* W, int K, int N, bf16* WT, int mode, LAS float* scr, int item, int lane) {
    const int nblk = N / 32, kb = item / nblk, nb = item % nblk, k0 = 64 * kb, n0 = 32 * nb;
#pragma unroll 8
    for (int i = 0; i < 32; ++i) { const int kk = 2 * i + (lane >> 5); scr[kk * 33 + (lane & 31)] = __builtin_nontemporal_load(W + (size_t)(k0 + kk) * N + n0 + (lane & 31)); }
    asm volatile("s_waitcnt lgkmcnt(0)" ::: "memory");
    int d0 = n0;
    if (mode == 1) { const int half = N / 2; d0 = (n0 < half) ? (n0 / 128) * 256 + (n0 % 128) : ((n0 - half) / 128) * 256 + 128 + ((n0 - half) % 128); }
    const int c = lane & 7;
#pragma unroll
    for (int j = 0; j < 4; ++j) { const int n = (lane >> 3) + 8 * j; const LAS float* s = scr + (8 * c) * 33 + n;
        u32x4 o; o.x = cvtpk(s[0 * 33], s[1 * 33]); o.y = cvtpk(s[2 * 33], s[3 * 33]); o.z = cvtpk(s[4 * 33], s[5 * 33]); o.w = cvtpk(s[6 * 33], s[7 * 33]);
        *(u32x4*)(WT + (size_t)(d0 + n) * K + k0 + 8 * c) = o; }
    asm volatile("s_waitcnt lgkmcnt(0)" ::: "memory");
}
__device__ __forceinline__ void convert_weight(const float* W, int K, int N, bf16* WT, int mode, LAS unsigned char* lds, int gw, int NGW, int wave, int lane) {
    LAS float* scr = (LAS float*)(lds + wave * 16384);
    const int nitems = (K / 64) * (N / 32);
    for (int it = gw; it < nitems; it += NGW) transpose_item(W, K, N, WT, mode, scr, it, lane);
}

__device__ __forceinline__ void p0_mods(const float* cin, const float* cctx, const float* adaw, const float* adab, float* mod, LAS unsigned char* lds, int bid, int G, int tid, int l_lo, int l_hi) {
    LAS float* sl = (LAS float*)lds;
    LAS float* red = (LAS float*)(lds + 12288);
    const int wave = tid >> 6, lane = tid & 63;
    for (int i = tid; i < 3 * D; i += NT) { const int mv = i / D, k = i % D; const float c = (mv < 2) ? cin[mv * D + k] : cctx[k]; sl[i] = c * sigmoidf_(c); }
    __syncthreads();
    for (int it = bid; it < (l_hi - l_lo) * 96; it += G) {
        const int l = l_lo + it / 96, n = (it % 96) * 64 + lane;
        const float* w = adaw + ((size_t)l * D + wave * 128) * (6 * D) + n;
        float a0 = 0.f, a1 = 0.f, a2 = 0.f;
#pragma unroll 32
        for (int k = 0; k < 128; ++k) { const float wv = __builtin_nontemporal_load(w + (size_t)k * (6 * D)); const int kk = wave * 128 + k; a0 += sl[kk] * wv; a1 += sl[D + kk] * wv; a2 += sl[2 * D + kk] * wv; }
        red[(wave * 3 + 0) * 64 + lane] = a0; red[(wave * 3 + 1) * 64 + lane] = a1; red[(wave * 3 + 2) * 64 + lane] = a2;
        __syncthreads();
        if (tid < 192) { const int mv = tid >> 6; float s = adab[l * 6 * D + n];
#pragma unroll
            for (int w8 = 0; w8 < 8; ++w8) s += red[(w8 * 3 + mv) * 64 + lane];
            mod[((size_t)l * 3 + mv) * 6 * D + n] = s; }
        __syncthreads();
    }
}

struct NormJob {
    const void* xl_src; const void* xc_src;
    void* xl_dst; void* xc_dst;
    const bf16* y;
    const float* nw_post; const float* gate;
    bf16* h; const float* nw_pre; const float* sh; const float* sc;
    int rows; int src_f32; int dst_f32; int pad;
};
#define NCB(q) (512 * ((q) >> 1) + 8 * lane + 4 * ((q) & 1))
__device__ __forceinline__ void norm_load_x(const NormJob& J, int row, int lane, f32x4 (&x)[4]) {
    if (J.src_f32) { const float* xs = row < ML ? (const float*)J.xl_src + (size_t)row * D : (const float*)J.xc_src + (size_t)(row - ML) * D;
#pragma unroll
        for (int q = 0; q < 4; ++q) x[q] = *(const f32x4*)(xs + NCB(q));
    } else { const bf16* xs = row < ML ? (const bf16*)J.xl_src + (size_t)row * D : (const bf16*)J.xc_src + (size_t)(row - ML) * D;
#pragma unroll
        for (int jj = 0; jj < 2; ++jj) { const u32x4 w = *(const u32x4*)(xs + 512 * jj + 8 * lane);
            x[2 * jj] = (f32x4){bflo(w.x), bfhi(w.x), bflo(w.y), bfhi(w.y)}; x[2 * jj + 1] = (f32x4){bflo(w.z), bfhi(w.z), bflo(w.w), bfhi(w.w)}; } }
}
__device__ __forceinline__ void norm_load_y(const NormJob& J, int row, int lane, u32x4 (&y)[2]) {
#pragma unroll
    for (int jj = 0; jj < 2; ++jj) y[jj] = *(const u32x4*)(J.y + (size_t)row * D + 512 * jj + 8 * lane);
}
struct NormParams { f32x4 nwp[4], g[4], nwq[4], sh[4], sc[4]; };
__device__ __forceinline__ void norm_load_mod(const NormJob& J, int mv, int lane, NormParams& Q) {
#pragma unroll
    for (int q = 0; q < 4; ++q) { const int c = NCB(q);
        if (J.y) Q.g[q] = *(const f32x4*)(J.gate + mv * 6 * D + c) * Q.nwp[q];
        if (J.h) { Q.sh[q] = *(const f32x4*)(J.sh + mv * 6 * D + c); Q.sc[q] = (1.f + *(const f32x4*)(J.sc + mv * 6 * D + c)) * Q.nwq[q]; } }
}
__device__ __forceinline__ void norm_row(const NormJob& J, int row, int lane, f32x4 (&x)[4], const u32x4 (&yb)[2], const NormParams& Q) {
    if (J.y) {
        f32x4 y[4]; float s = 0.f;
#pragma unroll
        for (int jj = 0; jj < 2; ++jj) { y[2 * jj] = (f32x4){bflo(yb[jj].x), bfhi(yb[jj].x), bflo(yb[jj].y), bfhi(yb[jj].y)}; y[2 * jj + 1] = (f32x4){bflo(yb[jj].z), bfhi(yb[jj].z), bflo(yb[jj].w), bfhi(yb[jj].w)}; }
#pragma unroll
        for (int q = 0; q < 4; ++q) s += (y[q].x * y[q].x + y[q].y * y[q].y) + (y[q].z * y[q].z + y[q].w * y[q].w);
        const float r = __builtin_amdgcn_rsqf(wave_sum(s) * (1.f / D) + EPS);
#pragma unroll
        for (int q = 0; q < 4; ++q) x[q] = x[q] + Q.g[q] * (y[q] * r);
        if (J.dst_f32) { float* xd = row < ML ? (float*)J.xl_dst + (size_t)row * D : (float*)J.xc_dst + (size_t)(row - ML) * D;
#pragma unroll
            for (int q = 0; q < 4; ++q) *(f32x4*)(xd + NCB(q)) = x[q];
        } else { bf16* xd = row < ML ? (bf16*)J.xl_dst + (size_t)row * D : (bf16*)J.xc_dst + (size_t)(row - ML) * D;
#pragma unroll
            for (int jj = 0; jj < 2; ++jj) { u32x4 w; w.x = cvtpk(x[2 * jj].x, x[2 * jj].y); w.y = cvtpk(x[2 * jj].z, x[2 * jj].w); w.z = cvtpk(x[2 * jj + 1].x, x[2 * jj + 1].y); w.w = cvtpk(x[2 * jj + 1].z, x[2 * jj + 1].w);
                *(u32x4*)(xd + 512 * jj + 8 * lane) = w;
                x[2 * jj] = (f32x4){bflo(w.x), bfhi(w.x), bflo(w.y), bfhi(w.y)}; x[2 * jj + 1] = (f32x4){bflo(w.z), bfhi(w.z), bflo(w.w), bfhi(w.w)}; } }
    }
    if (J.h) {
        float s = 0.f;
#pragma unroll
        for (int q = 0; q < 4; ++q) s += (x[q].x * x[q].x + x[q].y * x[q].y) + (x[q].z * x[q].z + x[q].w * x[q].w);
        const float r = __builtin_amdgcn_rsqf(wave_sum(s) * (1.f / D) + EPS);
        f32x4 o[4];
#pragma unroll
        for (int q = 0; q < 4; ++q) o[q] = (x[q] * r) * Q.sc[q] + Q.sh[q];
#pragma unroll
        for (int jj = 0; jj < 2; ++jj) { u32x4 w; w.x = cvtpk(o[2 * jj].x, o[2 * jj].y); w.y = cvtpk(o[2 * jj].z, o[2 * jj].w); w.z = cvtpk(o[2 * jj + 1].x, o[2 * jj + 1].y); w.w = cvtpk(o[2 * jj + 1].z, o[2 * jj + 1].w);
            *(u32x4*)(J.h + (size_t)row * D + 512 * jj + 8 * lane) = w; }
    }
}
__device__ __forceinline__ void norm_phase(const NormJob& J, int gw, int NGW, int lane) {
    const int base = J.rows / NGW, rem = J.rows % NGW;
    const int r0 = gw * base + (gw < rem ? gw : rem), r1 = r0 + base + (gw < rem ? 1 : 0);
    if (r0 >= r1) return;
    NormParams Q;
#pragma unroll
    for (int q = 0; q < 4; ++q) { const int c = NCB(q); Q.nwp[q] = J.y ? *(const f32x4*)(J.nw_post + c) : (f32x4){0.f, 0.f, 0.f, 0.f}; Q.nwq[q] = J.h ? *(const f32x4*)(J.nw_pre + c) : (f32x4){0.f, 0.f, 0.f, 0.f};
        Q.g[q] = Q.sh[q] = Q.sc[q] = (f32x4){0.f, 0.f, 0.f, 0.f}; }
    int cur_mv = -1;
    f32x4 xa[4], xb[4]; u32x4 ya[2], yb[2];
    const bool hy = J.y != nullptr;
    int row = r0;
    norm_load_x(J, row, lane, xa); if (hy) norm_load_y(J, row, lane, ya);
    if (row + 1 < r1) { norm_load_x(J, row + 1, lane, xb); if (hy) norm_load_y(J, row + 1, lane, yb); }
    for (; row < r1; ++row) {
        f32x4 x0[4]; u32x4 y0[2];
#pragma unroll
        for (int q = 0; q < 4; ++q) { x0[q] = xa[q]; xa[q] = xb[q]; }
#pragma unroll
        for (int jj = 0; jj < 2; ++jj) { y0[jj] = ya[jj]; ya[jj] = yb[jj]; }
        if (row + 2 < r1) { norm_load_x(J, row + 2, lane, xb); if (hy) norm_load_y(J, row + 2, lane, yb); }
        { const int mv = row < ML ? (row >> 13) : 2; if (mv != cur_mv) { norm_load_mod(J, mv, lane, Q); cur_mv = mv; } }
        norm_row(J, row, lane, x0, y0, Q);
    }
}
#undef NCB

__device__ __forceinline__ void ctx_gemm(const bf16* A, const bf16* Bt, int K, int N, bf16* Y, LAS unsigned char* lds, int bid, int G, int tid) {
    constexpr int CS = 528;
    constexpr int OFF_A = 0, OFF_B = 32 * CS, OFF_RED = 96 * CS;
    static_assert(OFF_RED + 65536 <= LDS_BYTES - 16, "ctx_gemm LDS map");
    const int wave = tid >> 6, lane = tid & 63, r = lane & 31, hh = lane >> 5;
    LAS float* red = (LAS float*)(lds + OFF_RED);
    const int ncb = N / 64, nch = K / 256;
    const int srow = tid >> 5, spc = tid & 31;
    for (int t = bid; t < 16 * ncb; t += G) {
        const int rb = t / ncb, cb = t % ncb;
        const bf16* ag = A + (size_t)(32 * rb + srow) * K + 8 * spc;
        const bf16* bg = Bt + (size_t)(64 * cb + srow) * K + 8 * spc;
        u32x4 pa[2], pb[4];
#pragma unroll
        for (int i = 0; i < 2; ++i) pa[i] = *(const u32x4*)(ag + (size_t)(16 * i) * K);
#pragma unroll
        for (int i = 0; i < 4; ++i) pb[i] = *(const u32x4*)(bg + (size_t)(16 * i) * K);
        f32x16 acc0, acc1;
#pragma unroll
        for (int i = 0; i < 16; ++i) { acc0[i] = 0.f; acc1[i] = 0.f; }
        for (int c = 0; c < nch; ++c) {
            __syncthreads();
#pragma unroll
            for (int i = 0; i < 2; ++i) *(LAS u32x4*)(lds + OFF_A + (srow + 16 * i) * CS + 16 * spc) = pa[i];
#pragma unroll
            for (int i = 0; i < 4; ++i) *(LAS u32x4*)(lds + OFF_B + (srow + 16 * i) * CS + 16 * spc) = pb[i];
            if (c + 1 < nch) {
#pragma unroll
                for (int i = 0; i < 2; ++i) pa[i] = *(const u32x4*)(ag + (size_t)(16 * i) * K + 256 * (c + 1));
#pragma unroll
                for (int i = 0; i < 4; ++i) pb[i] = *(const u32x4*)(bg + (size_t)(16 * i) * K + 256 * (c + 1));
            }
            __syncthreads();
#pragma unroll
            for (int s = 0; s < 2; ++s) { const int ko = (32 * wave + 16 * s + 8 * hh) * 2;
                const bf16x8 a = *(const LAS bf16x8*)(lds + OFF_A + r * CS + ko);
                const bf16x8 b0 = *(const LAS bf16x8*)(lds + OFF_B + r * CS + ko), b1 = *(const LAS bf16x8*)(lds + OFF_B + (32 + r) * CS + ko);
                acc0 = MFMA32(a, b0, acc0); acc1 = MFMA32(a, b1, acc1); }
        }
#pragma unroll
        for (int i = 0; i < 16; ++i) { red[(wave * 32 + i) * 64 + lane] = acc0[i]; red[(wave * 32 + 16 + i) * 64 + lane] = acc1[i]; }
        __syncthreads();
#pragma unroll
        for (int q = 0; q < 4; ++q) { const int ri = wave + 8 * q;
            float s = 0.f;
#pragma unroll
            for (int w8 = 0; w8 < 8; ++w8) s += red[(w8 * 32 + ri) * 64 + lane];
            const int ti = ri >> 4, i = ri & 15; const int row = 32 * rb + crow(i, hh), col = 64 * cb + 32 * ti + r;
            Y[(size_t)row * N + col] = (bf16)f2bf(s); }
    }
    __syncthreads();
}

__device__ __forceinline__ void conv_phase(const bf16* P, const float* cw, bf16* R, int rows, int gt, int GT) {
    const int total = (rows / 8) * 128;
    for (int it = gt; it < total; it += GT) {
        const int row0 = (it >> 7) * 8, c0 = (it & 127) * 8;
        bool hl, hr;
        if (row0 < ML) { const int t = row0 & 63; hl = t != 0; hr = t != 56; } else { const int t = (row0 - ML) & 255; hl = t != 0; hr = t != 248; }
        const bf16* p = P + (size_t)row0 * 3072 + c0;
        u32x4 gc[10], xi[10], gb[8];
#pragma unroll
        for (int i = 0; i < 10; ++i) { const bool ok = (i == 0) ? hl : (i == 9 ? hr : true);
            if (ok) { gc[i] = *(const u32x4*)(p + (size_t)(i - 1) * 3072 + 1024); xi[i] = *(const u32x4*)(p + (size_t)(i - 1) * 3072 + 2048); }
            else { gc[i] = (u32x4){0, 0, 0, 0}; xi[i] = (u32x4){0, 0, 0, 0}; } }
#pragma unroll
        for (int i = 0; i < 8; ++i) gb[i] = *(const u32x4*)(p + (size_t)i * 3072);
        float w0[8], w1[8], w2[8];
#pragma unroll
        for (int q = 0; q < 2; ++q) { const f32x4 a0 = *(const f32x4*)(cw + c0 + 4 * q), a1 = *(const f32x4*)(cw + D + c0 + 4 * q), a2 = *(const f32x4*)(cw + 2 * D + c0 + 4 * q);
#pragma unroll
            for (int i = 0; i < 4; ++i) { w0[4 * q + i] = a0[i]; w1[4 * q + i] = a1[i]; w2[4 * q + i] = a2[i]; } }
        float up[8], uc[8], un[8];
#pragma unroll
        for (int c = 0; c < 4; ++c) { up[2 * c] = bflo(gc[0][c]) * bflo(xi[0][c]); up[2 * c + 1] = bfhi(gc[0][c]) * bfhi(xi[0][c]); uc[2 * c] = bflo(gc[1][c]) * bflo(xi[1][c]); uc[2 * c + 1] = bfhi(gc[1][c]) * bfhi(xi[1][c]); }
#pragma unroll
        for (int i = 0; i < 8; ++i) {
#pragma unroll
            for (int c = 0; c < 4; ++c) { un[2 * c] = bflo(gc[i + 2][c]) * bflo(xi[i + 2][c]); un[2 * c + 1] = bfhi(gc[i + 2][c]) * bfhi(xi[i + 2][c]); }
            u32x4 o;
#pragma unroll
            for (int c = 0; c < 4; ++c) { const float yl = up[2 * c] * w0[2 * c] + uc[2 * c] * w1[2 * c] + un[2 * c] * w2[2 * c], yh = up[2 * c + 1] * w0[2 * c + 1] + uc[2 * c + 1] * w1[2 * c + 1] + un[2 * c + 1] * w2[2 * c + 1];
                o[c] = cvtpk(bflo(gb[i][c]) * yl, bfhi(gb[i][c]) * yh); }
            *(u32x4*)(R + (size_t)(row0 + i) * D + c0) = o;
#pragma unroll
            for (int c = 0; c < 8; ++c) { up[c] = uc[c]; uc[c] = un[c]; }
        }
    }
}

__device__ __forceinline__ int unit_row0(int b, int cid) { return cid < 4 ? ML + b * CTXL + cid * 64 : b * SEQ + (cid - 4) * 64; }
__device__ __forceinline__ size_t slot_index(int b, int h, int dir, int cid) { return (size_t)(((b * NH + h) * 2 + dir) * NCH + cid); }
__device__ __forceinline__ float lower_bound_of(const float* hlb, int j, int d) { return j == 0 ? 0.f : sigmoidf_(hlb[D + d] - hlb[d]); }

constexpr float LOG2E = 1.4426950408889634f;
#define GATE1(zv, lbv, omlv, lfo, kko) do { const float e_ = __builtin_amdgcn_exp2f(-(zv) * LOG2E); const float sg_ = __builtin_amdgcn_rcpf(1.f + e_); \
    lfo = __builtin_amdgcn_logf(fmaxf(__builtin_fmaf(omlv, sg_, lbv), F_FLOOR)); kko = __builtin_fmaf(-(omlv), sg_, omlv); } while (0)
#define GATE2(zw_, lb2_, om2_, lfo, kko) do { const f32x2 a_ = (f32x2){bflo(zw_), bfhi(zw_)} * (-LOG2E); \
    const f32x2 s_ = (f32x2){__builtin_amdgcn_exp2f(a_.x), __builtin_amdgcn_exp2f(a_.y)} + 1.f; \
    const f32x2 sg_ = (f32x2){__builtin_amdgcn_rcpf(s_.x), __builtin_amdgcn_rcpf(s_.y)}; \
    const f32x2 f_ = om2_ * sg_ + lb2_; \
    lfo = (f32x2){__builtin_amdgcn_logf(fmaxf(f_.x, F_FLOOR)), __builtin_amdgcn_logf(fmaxf(f_.y, F_FLOOR))}; kko = om2_ - om2_ * sg_; } while (0)

__device__ void scan_pass_a(const bf16* P, const float* hlb, int j, bf16* S, float* DEC, LAS unsigned char* lds, int bid, int G, int tid) {
    constexpr int KE_STRIDE = 72 * 2, BUF = 3 * 128 * KE_STRIDE;
    constexpr int OFF_TOT = 2 * BUF;
    static_assert(OFF_TOT + 4096 <= LDS_BYTES - 16, "pass A LDS map");
    const int wave = tid >> 6, lane = tid & 63, r = lane & 31, hh = lane >> 5;
    const int dir = wave >> 2, qt = wave & 3, kp = lane;
    LAS float* tot = (LAS float*)(lds + OFF_TOT);
    const int NU = NB * NH * NCH;
    int par = 0;
    unsigned zw[16]; u32x4 v0, v1;
    f32x2 hla = (f32x2){0.f, 0.f}, hlb2 = (f32x2){0.f, 0.f};
    int u = bid;
    if (u < NU) { const int b = u / (NH * NCH), h = (u / NCH) % NH, cid = u % NCH; const int row0 = unit_row0(b, cid);
        const bf16* zp = P + (size_t)(row0 + 16 * qt) * 5120 + 2048 + dir * 1024 + h * HD + 2 * kp;
#pragma unroll
        for (int s = 0; s < 16; ++s) zw[s] = *(const unsigned*)(zp + (size_t)s * 5120);
        const bf16* vp = P + (size_t)(row0 + lane) * 5120 + 1024 + h * HD + 16 * wave; v0 = *(const u32x4*)vp; v1 = *(const u32x4*)(vp + 8);  if (j != 0) { hla = *(const f32x2*)(hlb + h * HD + 2 * kp); hlb2 = *(const f32x2*)(hlb + D + h * HD + 2 * kp); } }
    for (; u < NU; u += G, par ^= 1) {
        const int b = u / (NH * NCH), h = (u / NCH) % NH, cid = u % NCH;
        LAS unsigned char* buf = lds + par * BUF;
        { LAS bf16* vt = (LAS bf16*)(buf + 2 * 128 * KE_STRIDE) + (16 * wave) * 72 + lane;
#pragma unroll
          for (int i = 0; i < 4; ++i) { vt[(2 * i) * 72] = (bf16)(v0[i] & 0xffffu); vt[(2 * i + 1) * 72] = (bf16)(v0[i] >> 16); vt[(8 + 2 * i) * 72] = (bf16)(v1[i] & 0xffffu); vt[(8 + 2 * i + 1) * 72] = (bf16)(v1[i] >> 16); } }
        const int ch = h * HD + 2 * kp;
        const float lb0 = j == 0 ? 0.f : sigmoidf_(hlb2.x - hla.x), lb1 = j == 0 ? 0.f : sigmoidf_(hlb2.y - hla.y), om0 = 1.f - lb0, om1 = 1.f - lb1; (void)ch;
        float lf0[16], lf1[16], k0[16], k1[16];
        float t0 = 0.f, t1 = 0.f;
#pragma unroll
        for (int s = 0; s < 16; ++s) { GATE1(bflo(zw[s]), lb0, om0, lf0[s], k0[s]); GATE1(bfhi(zw[s]), lb1, om1, lf1[s], k1[s]); t0 += lf0[s]; t1 += lf1[s]; }
        *(LAS f32x2*)(tot + (dir * 4 + qt) * 128 + 2 * kp) = (f32x2){t0, t1};
        { const int un = u + G; if (un < NU) { const int bn = un / (NH * NCH), hn = (un / NCH) % NH, cn = un % NCH; const int rown = unit_row0(bn, cn);
            const bf16* zp = P + (size_t)(rown + 16 * qt) * 5120 + 2048 + dir * 1024 + hn * HD + 2 * kp;
#pragma unroll
            for (int s = 0; s < 16; ++s) zw[s] = *(const unsigned*)(zp + (size_t)s * 5120);
            const bf16* vp = P + (size_t)(rown + lane) * 5120 + 1024 + hn * HD + 16 * wave; v0 = *(const u32x4*)vp; v1 = *(const u32x4*)(vp + 8);  if (j != 0) { hla = *(const f32x2*)(hlb + hn * HD + 2 * kp); hlb2 = *(const f32x2*)(hlb + D + hn * HD + 2 * kp); } } }
        __syncthreads();
        float T0 = 0.f, T1 = 0.f, c0 = 0.f, c1 = 0.f;
#pragma unroll
        for (int q = 0; q < 4; ++q) { const f32x2 tq = *(const LAS f32x2*)(tot + (dir * 4 + q) * 128 + 2 * kp); T0 += tq.x; T1 += tq.y;
            const bool before = dir == 0 ? (q < qt) : (q > qt); if (before) { c0 += tq.x; c1 += tq.y; } }
        { unsigned w0[8], w1[8];
          if (dir == 0) {
#pragma unroll
              for (int s = 0; s < 16; ++s) { c0 += lf0[s]; c1 += lf1[s]; k0[s] *= __builtin_amdgcn_exp2f(T0 - c0); k1[s] *= __builtin_amdgcn_exp2f(T1 - c1); }
          } else {
#pragma unroll
              for (int s = 15; s >= 0; --s) { c0 += lf0[s]; c1 += lf1[s]; k0[s] *= __builtin_amdgcn_exp2f(T0 - c0); k1[s] *= __builtin_amdgcn_exp2f(T1 - c1); }
          }
#pragma unroll
          for (int i = 0; i < 8; ++i) { w0[i] = cvtpk(k0[2 * i], k0[2 * i + 1]); w1[i] = cvtpk(k1[2 * i], k1[2 * i + 1]); }
          LAS u32x4* p0 = (LAS u32x4*)(buf + (dir * 128 + 2 * kp) * KE_STRIDE + 32 * qt);
          LAS u32x4* p1 = (LAS u32x4*)(buf + (dir * 128 + 2 * kp + 1) * KE_STRIDE + 32 * qt);
          p0[0] = (u32x4){w0[0], w0[1], w0[2], w0[3]}; p0[1] = (u32x4){w0[4], w0[5], w0[6], w0[7]};
          p1[0] = (u32x4){w1[0], w1[1], w1[2], w1[3]}; p1[1] = (u32x4){w1[4], w1[5], w1[6], w1[7]}; }
        if (qt == 0) *(f32x2*)(DEC + slot_index(b, h, dir, cid) * 128 + 2 * kp) = (f32x2){__builtin_amdgcn_exp2f(T0), __builtin_amdgcn_exp2f(T1)};
        __syncthreads();
        { const int wd = wave >> 2, kt = wave & 3;
          bf16x8 af[4];
#pragma unroll
          for (int st = 0; st < 4; ++st) af[st] = *(const LAS bf16x8*)(buf + (wd * 128 + 32 * kt + r) * KE_STRIDE + (16 * st + 8 * hh) * 2);
          bf16* sp = S + slot_index(b, h, wd, cid) * (128 * 128);
#pragma unroll
          for (int vt_ = 0; vt_ < 4; ++vt_) {
              f32x16 acc;
#pragma unroll
              for (int i = 0; i < 16; ++i) acc[i] = 0.f;
#pragma unroll
              for (int st = 0; st < 4; ++st) { const bf16x8 bfr = *(const LAS bf16x8*)(buf + 2 * 128 * KE_STRIDE + (32 * vt_ + r) * KE_STRIDE + (16 * st + 8 * hh) * 2); acc = MFMA32(af[st], bfr, acc); }
#pragma unroll
              for (int g = 0; g < 4; ++g) { u32x2 w; w.x = pk2(acc[4 * g], acc[4 * g + 1]); w.y = pk2(acc[4 * g + 2], acc[4 * g + 3]);
                  *(u32x2*)(sp + ((vt_ * 8 + 2 * kt + (g >> 1)) * 64 + (g & 1) * 32 + r) * 8 + 4 * hh) = w; }
          } }
    }
}

__device__ void scan_pass_b(bf16* S, const float* DEC, LAS unsigned char* lds, int bid, int G, int tid) {
  LAS float* dl = (LAS float*)lds;
  for (int blk = bid; blk < NB * NH * 2 * 8; blk += G) {
    const int seq = blk >> 3, e4 = (blk & 7) * 512 + tid;
    const int dir = seq & 1;
    const int e = 4 * e4, k4 = 16 * ((e >> 9) & 7) + 8 * ((e >> 8) & 1) + (e & 7);
    __syncthreads();
    { const f32x4* src = (const f32x4*)(DEC + (size_t)seq * NCH * 128);
      for (int i = tid; i < NCH * 32; i += NT) ((LAS f32x4*)dl)[i] = src[i]; }
    __syncthreads();
    bf16* base = S + (size_t)seq * NCH * 16384 + e;
    float s0 = 0.f, s1 = 0.f, s2 = 0.f, s3 = 0.f;
    constexpr int GP = 22;
    u32x2 Lc[GP];
#pragma unroll
    for (int q = 0; q < GP; ++q) { const int cid = dir == 0 ? q : (q < 4 ? 3 - q : 135 - q); Lc[q] = *(const u32x2*)(base + (size_t)cid * 16384); }
    for (int p = 0; p < NCH; p += GP) {
        u32x2 Ln[GP];
        if (p + GP < NCH) {
#pragma unroll
            for (int q = 0; q < GP; ++q) { const int pp = p + GP + q; const int cid = dir == 0 ? pp : (pp < 4 ? 3 - pp : 135 - pp); Ln[q] = *(const u32x2*)(base + (size_t)cid * 16384); }
        }
#pragma unroll
        for (int q = 0; q < GP; ++q) { const int pp = p + q; const int cid = dir == 0 ? pp : (pp < 4 ? 3 - pp : 135 - pp);
            u32x2 w; w.x = cvtpk(s0, s1); w.y = cvtpk(s2, s3);
            *(u32x2*)(base + (size_t)cid * 16384) = w;
            const f32x4 dq = *(const LAS f32x4*)(dl + cid * 128 + k4);
            s0 = dq.x * s0 + bflo(Lc[q].x); s1 = dq.y * s1 + bfhi(Lc[q].x); s2 = dq.z * s2 + bflo(Lc[q].y); s3 = dq.w * s3 + bfhi(Lc[q].y); }
#pragma unroll
        for (int q = 0; q < GP; ++q) Lc[q] = Ln[q];
    }
  }
}

__device__ void scan_pass_c(const bf16* P, const float* hlb, const float* gnorm, int j, const bf16* S, bf16* R, LAS unsigned char* lds, int bid, int G, int tid, int cid_lo) {
    constexpr int QS = 136 * 2, PS = 72 * 2;
    constexpr int OFF_QI = 0, OFF_QS = 2 * 64 * QS, OFF_KS = 4 * 64 * QS, OFF_VT = 6 * 64 * QS, OFF_P = OFF_VT + 128 * PS, OFF_TOT = OFF_P + 2 * 64 * PS;
    constexpr int OFF_O = OFF_QS;
    static_assert(OFF_TOT + 4096 <= LDS_BYTES - 16 && OFF_O + 64 * 132 * 4 <= OFF_KS, "pass C LDS map");
    const int wave = tid >> 6, lane = tid & 63, r = lane & 31, hh = lane >> 5;
    const int dir = wave >> 2, qt = wave & 3, kp = lane;
    LAS float* tot = (LAS float*)(lds + OFF_TOT);
    const int ncid = NCH - cid_lo, NU = NB * NH * ncid;
    unsigned zw[16], qw[16]; u32x4 v0, v1;
    float gnv[16];
#pragma unroll
    for (int i = 0; i < 16; ++i) gnv[i] = gnorm[(tid & 7) * 16 + i];
    f32x2 hla = (f32x2){0.f, 0.f}, hlb2 = (f32x2){0.f, 0.f};
    int u = bid;
    if (u < NU) { const int b = u / (NH * ncid), h = (u / ncid) % NH, cid = cid_lo + u % ncid; const int row0 = unit_row0(b, cid);
        const bf16* zp = P + (size_t)(row0 + 16 * qt) * 5120 + 2048 + dir * 1024 + h * HD + 2 * kp;
        const bf16* qp = P + (size_t)(row0 + 16 * qt) * 5120 + h * HD + 2 * kp;
#pragma unroll
        for (int s = 0; s < 16; ++s) { zw[s] = *(const unsigned*)(zp + (size_t)s * 5120); qw[s] = *(const unsigned*)(qp + (size_t)s * 5120); }
        const bf16* vp = P + (size_t)(row0 + lane) * 5120 + 1024 + h * HD + 16 * wave; v0 = *(const u32x4*)vp; v1 = *(const u32x4*)(vp + 8);  if (j != 0) { hla = *(const f32x2*)(hlb + h * HD + 2 * kp); hlb2 = *(const f32x2*)(hlb + D + h * HD + 2 * kp); } }
    for (; u < NU; u += G) {
        const int b = u / (NH * ncid), h = (u / ncid) % NH, cid = cid_lo + u % ncid;
        const int row0 = unit_row0(b, cid);
        { LAS bf16* vt = (LAS bf16*)(lds + OFF_VT) + (16 * wave) * 72 + lane;
#pragma unroll
          for (int i = 0; i < 4; ++i) { vt[(2 * i) * 72] = (bf16)(v0[i] & 0xffffu); vt[(2 * i + 1) * 72] = (bf16)(v0[i] >> 16); vt[(8 + 2 * i) * 72] = (bf16)(v1[i] & 0xffffu); vt[(8 + 2 * i + 1) * 72] = (bf16)(v1[i] >> 16); } }
        const int ch = h * HD + 2 * kp;
        const float lb0 = j == 0 ? 0.f : sigmoidf_(hlb2.x - hla.x), lb1 = j == 0 ? 0.f : sigmoidf_(hlb2.y - hla.y), om0 = 1.f - lb0, om1 = 1.f - lb1; (void)ch;
        const f32x2 lb2 = (f32x2){lb0, lb1}, om2 = (f32x2){om0, om1};
        f32x2 lf[16], kk[16];
        f32x2 t2 = (f32x2){0.f, 0.f};
#pragma unroll
        for (int s = 0; s < 16; ++s) { GATE2(zw[s], lb2, om2, lf[s], kk[s]); t2 += lf[s]; }
        *(LAS f32x2*)(tot + (dir * 4 + qt) * 128 + 2 * kp) = t2;
        __syncthreads();
        f32x2 c2 = (f32x2){0.f, 0.f}, m2 = (f32x2){0.f, 0.f};
#pragma unroll
        for (int q = 0; q < 4; ++q) { const f32x2 tq = *(const LAS f32x2*)(tot + (dir * 4 + q) * 128 + 2 * kp);
            const bool before = dir == 0 ? (q < qt) : (q > qt); if (before) c2 += tq;
            const bool inref = dir == 0 ? (q < 2) : (q >= 2); if (inref) m2 += tq; }
        {
            LAS unsigned* qi = (LAS unsigned*)(lds + OFF_QI + dir * 64 * QS + (16 * qt) * QS) + kp;
            LAS unsigned* qs = (LAS unsigned*)(lds + OFF_QS + dir * 64 * QS + (16 * qt) * QS) + kp;
            LAS unsigned* ks = (LAS unsigned*)(lds + OFF_KS + dir * 64 * QS + (16 * qt) * QS) + kp;
            const float qscale = 0.08838834764831845f;
            const bool fast = __builtin_amdgcn_ballot_w64(!(m2.x > -100.f && m2.y > -100.f)) == 0ull;
            const f32x2 em2 = (f32x2){__builtin_amdgcn_exp2f(m2.x), __builtin_amdgcn_exp2f(m2.y)};
#define PC_STEP(s, FAST) do { c2 += lf[s]; \
                const f32x2 q2 = (f32x2){bflo(qw[s]), bfhi(qw[s])} * qscale; \
                const f32x2 d2 = c2 - m2; \
                const f32x2 e2 = (f32x2){__builtin_amdgcn_exp2f(__builtin_amdgcn_fmed3f(d2.x, -115.f, 115.f)), __builtin_amdgcn_exp2f(__builtin_amdgcn_fmed3f(d2.y, -115.f, 115.f))}; \
                const f32x2 E2 = (FAST) ? e2 * em2 : (f32x2){__builtin_amdgcn_exp2f(c2.x), __builtin_amdgcn_exp2f(c2.y)}; \
                const f32x2 qi2 = q2 * E2, qs2 = q2 * e2, ks2 = kk[s] * (f32x2){__builtin_amdgcn_rcpf(e2.x), __builtin_amdgcn_rcpf(e2.y)}; \
                qi[(s) * (QS / 4)] = cvtpk(qi2.x, qi2.y); qs[(s) * (QS / 4)] = cvtpk(qs2.x, qs2.y); ks[(s) * (QS / 4)] = cvtpk(ks2.x, ks2.y); } while (0)
            if (fast) {
                if (dir == 0) {
#pragma unroll
                    for (int s = 0; s < 16; ++s) PC_STEP(s, true);
                } else {
#pragma unroll
                    for (int s = 15; s >= 0; --s) PC_STEP(s, true);
                }
            } else {
                if (dir == 0) {
#pragma unroll
                    for (int s = 0; s < 16; ++s) PC_STEP(s, false);
                } else {
#pragma unroll
                    for (int s = 15; s >= 0; --s) PC_STEP(s, false);
                }
            }
#undef PC_STEP
        }
        const int rt = wave & 1, ct = wave >> 1;
        bf16x8 sb[2][8];
#pragma unroll
        for (int d = 0; d < 2; ++d) { const bf16* sp = S + slot_index(b, h, d, cid) * (128 * 128) + (size_t)(ct * 8 * 64 + lane) * 8;
#pragma unroll
            for (int st = 0; st < 8; ++st) sb[d][st] = *(const bf16x8*)(sp + st * 512); }
        const bf16* gp_ = P + (size_t)(row0 + (tid >> 3)) * 5120 + 4096 + h * HD + (tid & 7) * 16;
        const u32x4 g0 = *(const u32x4*)gp_, g1 = *(const u32x4*)(gp_ + 8);
        __syncthreads();
        { const int wd = wave >> 2, tt = (wave >> 1) & 1, st_ = wave & 1;
          f32x16 acc;
#pragma unroll
          for (int i = 0; i < 16; ++i) acc[i] = 0.f;
          const bool dead = (wd == 0) ? (st_ > tt) : (st_ < tt);
          if (!dead) {
#pragma unroll
              for (int st = 0; st < 8; ++st) {
                  const bf16x8 af = *(const LAS bf16x8*)(lds + OFF_QS + wd * 64 * QS + (32 * tt + r) * QS + (16 * st + 8 * hh) * 2);
                  const bf16x8 bfr = *(const LAS bf16x8*)(lds + OFF_KS + wd * 64 * QS + (32 * st_ + r) * QS + (16 * st + 8 * hh) * 2);
                  acc = MFMA32(af, bfr, acc);
              }
          }
          LAS bf16* pp = (LAS bf16*)(lds + OFF_P + wd * 64 * PS);
#pragma unroll
          for (int i = 0; i < 16; ++i) { const int tq = 32 * tt + crow(i, hh), sq = 32 * st_ + r; const bool keep = (wd == 0) ? (sq <= tq) : (sq >= tq);
              pp[tq * 72 + sq] = (bf16)(cvtpk(keep ? acc[i] : 0.f, 0.f) & 0xffffu); }
        }
        __syncthreads();
        { const int un = u + G; if (un < NU) { const int bn = un / (NH * ncid), hn = (un / ncid) % NH, cn = cid_lo + un % ncid; const int rown = unit_row0(bn, cn);
            const bf16* zp = P + (size_t)(rown + 16 * qt) * 5120 + 2048 + dir * 1024 + hn * HD + 2 * kp;
            const bf16* qp = P + (size_t)(rown + 16 * qt) * 5120 + hn * HD + 2 * kp;
#pragma unroll
            for (int s = 0; s < 16; ++s) { zw[s] = *(const unsigned*)(zp + (size_t)s * 5120); qw[s] = *(const unsigned*)(qp + (size_t)s * 5120); }
            const bf16* vp = P + (size_t)(rown + lane) * 5120 + 1024 + hn * HD + 16 * wave; v0 = *(const u32x4*)vp; v1 = *(const u32x4*)(vp + 8);  if (j != 0) { hla = *(const f32x2*)(hlb + hn * HD + 2 * kp); hlb2 = *(const f32x2*)(hlb + D + hn * HD + 2 * kp); } } }
        f32x16 o;
#pragma unroll
        for (int i = 0; i < 16; ++i) o[i] = 0.f;
#pragma unroll
        for (int d = 0; d < 2; ++d) {
#pragma unroll
            for (int st = 0; st < 8; ++st) { const bf16x8 af = *(const LAS bf16x8*)(lds + OFF_QI + d * 64 * QS + (32 * rt + r) * QS + (16 * st + 8 * hh) * 2); o = MFMA32(af, sb[d][st], o); }
#pragma unroll
            for (int st = 0; st < 4; ++st) { const bf16x8 af = *(const LAS bf16x8*)(lds + OFF_P + d * 64 * PS + (32 * rt + r) * PS + (16 * st + 8 * hh) * 2);
                const bf16x8 bfr = *(const LAS bf16x8*)(lds + OFF_VT + (32 * ct + r) * PS + (16 * st + 8 * hh) * 2); o = MFMA32(af, bfr, o); }
        }
        { LAS float* os = (LAS float*)(lds + OFF_O);
#pragma unroll
          for (int i = 0; i < 16; ++i) os[(32 * rt + crow(i, hh)) * 132 + 32 * ct + r] = o[i]; }
        __syncthreads();
        { const int tq = tid >> 3, c0_ = (tid & 7) * 16;
          const LAS float* os = (const LAS float*)(lds + OFF_O) + tq * 132 + c0_;
          float v[16]; float ss = 0.f;
#pragma unroll
          for (int q = 0; q < 4; ++q) { const f32x4 x = *(const LAS f32x4*)(os + 4 * q); v[4 * q] = x.x; v[4 * q + 1] = x.y; v[4 * q + 2] = x.z; v[4 * q + 3] = x.w; ss += (x.x * x.x + x.y * x.y) + (x.z * x.z + x.w * x.w); }
          ss += dpp_xor1(ss); ss += dpp_xor2(ss); ss += dpp_hmir(ss);
          const float rs = __builtin_amdgcn_rsqf(ss * (1.f / HD) + EPS);
          float gv[16];
#pragma unroll
          for (int i = 0; i < 4; ++i) { gv[2 * i] = bflo(g0[i]); gv[2 * i + 1] = bfhi(g0[i]); gv[8 + 2 * i] = bflo(g1[i]); gv[8 + 2 * i + 1] = bfhi(g1[i]); }
          float ov[16];
#pragma unroll
          for (int i = 0; i < 16; ++i) { const float gg = gv[i]; ov[i] = v[i] * rs * gnv[i] * (gg * sigmoidf_(gg)); }
          u32x4 w0, w1;
#pragma unroll
          for (int i = 0; i < 4; ++i) { w0[i] = cvtpk(ov[2 * i], ov[2 * i + 1]); w1[i] = cvtpk(ov[8 + 2 * i], ov[8 + 2 * i + 1]); }
          bf16* rp = R + (size_t)(row0 + tq) * D + h * HD + c0_;
          *(u32x4*)rp = w0; *(u32x4*)(rp + 8) = w1; }
    }
}
typedef __attribute__((address_space(1))) unsigned gu32;
#define XB_TMO      128
#define XB_XCNT(j)  (256  + 64 * (j))
#define XB_XSUB(j)  (1280 + 64 * (j))
#define XB_XGEN(j)  (2304 + 64 * (j))
#define XB_TOP      3328
#define XB_TOPGEN   3392
#define XCD_BAR_WORDS 3456
#define XB_SPIN_CAP (1u << 18)

__device__ __forceinline__ unsigned xb_ld(unsigned* p)              { return __hip_atomic_load(p, __ATOMIC_RELAXED, __HIP_MEMORY_SCOPE_AGENT); }
__device__ __forceinline__ unsigned xb_add(unsigned* p, unsigned v) { return __hip_atomic_fetch_add(p, v, __ATOMIC_RELAXED, __HIP_MEMORY_SCOPE_AGENT); }
__device__ __forceinline__ unsigned xb_xcc_id() { return (unsigned)__builtin_amdgcn_s_getreg((3 << 11) | 20) & 0xFu; }
#define XB_SPIN(cond, bar) do { unsigned _sp = 0; while (cond) { __builtin_amdgcn_s_sleep(1); \
    if ((++_sp & 255u) == 0u) { if (xb_ld(&(bar)[XB_TMO])) break; if (_sp > XB_SPIN_CAP) { atomicAdd(&(bar)[XB_TMO], 1u); break; } } } } while (0)

struct XcdBarrier {
    unsigned* bar; unsigned x;
    volatile LAS unsigned* st;
};

__device__ __forceinline__ XcdBarrier xcd_barrier_post(unsigned* bar, volatile LAS unsigned* st) {
    XcdBarrier b; b.bar = bar; b.x = xb_xcc_id(); b.st = st;
    if (threadIdx.x == 0) (void)xb_add(&bar[XB_XCNT(b.x)], 1u);
    return b;
}
__device__ __forceinline__ void xcd_barrier_complete(unsigned* bar, unsigned x, unsigned& nloc, unsigned& nx) {
    const unsigned G = gridDim.x * gridDim.y * gridDim.z;
    unsigned sum, cnt, mine, sp = 0u;
    for (;;) {
        sum = 0u; cnt = 0u; mine = 0u;
#pragma unroll
        for (unsigned j = 0; j < 16; ++j) { const unsigned c = xb_ld(&bar[XB_XCNT(j)]); sum += c; cnt += (c > 0u) ? 1u : 0u; mine = (j == x) ? c : mine; }
        if (sum == G) break;
        __builtin_amdgcn_s_sleep(1);
        if ((++sp & 255u) == 0u) { if (xb_ld(&bar[XB_TMO])) break; if (sp > XB_SPIN_CAP) { atomicAdd(&bar[XB_TMO], 1u); break; } }
    }
    nloc = mine > 0u ? mine : 1u; nx = cnt > 0u ? cnt : 1u;
}

__device__ __forceinline__ void xcd_barrier(const XcdBarrier& b) {
    asm volatile("s_waitcnt vmcnt(0)" ::: "memory");
    __syncthreads();
    if (threadIdx.x == 0) {
        unsigned* bar = b.bar;
        __builtin_amdgcn_s_waitcnt(0);
        unsigned nloc = b.st[0], nx = b.st[1];
        if (nloc == 0u) { xcd_barrier_complete(bar, b.x, nloc, nx); b.st[0] = nloc; b.st[1] = nx; }
        const unsigned old = xb_add(&bar[XB_XSUB(b.x)], 1u);
        const unsigned gen = old / nloc;
        if (old + 1u == (gen + 1u) * nloc) {
            __builtin_amdgcn_fence(__ATOMIC_RELEASE, "agent");
            asm volatile("s_waitcnt vmcnt(0)" ::: "memory");
            const unsigned og = xb_add(&bar[XB_TOP], 1u);
            const unsigned tg = og / nx;
            if (og + 1u == (tg + 1u) * nx) xb_add(&bar[XB_TOPGEN], 1u);
            else XB_SPIN(xb_ld(&bar[XB_TOPGEN]) == tg, bar);
            __builtin_amdgcn_fence(__ATOMIC_ACQUIRE, "agent");
            xb_add(&bar[XB_XGEN(b.x)], 1u);
            asm volatile("s_waitcnt vmcnt(0)" ::: "memory");
        } else {
            XB_SPIN(xb_ld(&bar[XB_XGEN(b.x)]) == gen, bar);
            __builtin_amdgcn_fence(__ATOMIC_ACQUIRE, "agent");
            asm volatile("s_waitcnt vmcnt(0)" ::: "memory");
        }
    }
    __syncthreads();
}

#define AS4 __attribute__((address_space(4)))
#define PH_BEGIN() \
    asm volatile("" : "+s"(ap) :: "memory"); \
    int tid_ = threadIdx.x; asm volatile("" : "+v"(tid_)); const int tid = tid_, lane = tid & 63, wave = __builtin_amdgcn_readfirstlane(tid >> 6); \
    int bid_ = blockIdx.x; asm volatile("" : "+s"(bid_)); const int G = gridDim.x, bid = bid_; \
    const int gw = bid * NWAVES + wave, NGW = G * NWAVES, gt = bid * NT + tid, GT = G * NT; \
    unsigned char* ws = ap->ws; float* mod = (float*)(ws + WS_MOD); \
    bf16* Wmi = (bf16*)(ws + WS_WMI); bf16* Wmo = (bf16*)(ws + WS_WMO); bf16* Wf1 = (bf16*)(ws + WS_WF1); bf16* Wf2 = (bf16*)(ws + WS_WF2); \
    bf16* XC = (bf16*)(ws + WS_XC); bf16* XB = (bf16*)((unsigned char*)ap->out + 32 * MiB); bf16* XT = (bf16*)(ws + WS_P + 125 * MiB); (void)XB; (void)XT; bf16* H = (bf16*)(ws + WS_H); bf16* P = (bf16*)(ws + WS_P); \
    bf16* Y1 = (bf16*)(ws + WS_Y1); bf16* A = (bf16*)(ws + WS_A); bf16* Y2 = (bf16*)(ws + WS_Y2); \
    bf16* S = (bf16*)(ws + WS_S); float* DEC = (float*)(ws + WS_DEC); \
    (void)lane; (void)gw; (void)NGW; (void)gt; (void)GT; (void)mod; (void)Wmi; (void)Wmo; (void)Wf1; (void)Wf2; (void)XC; (void)H; (void)P; (void)Y1; (void)A; (void)Y2; (void)S; (void)DEC; (void)bid; (void)G;
#define IN(i) (ap->in[i])
#ifndef GEMM_REP
#define GEMM_REP 1
#endif
#ifndef SYNC_REP
#define SYNC_REP 1
#endif
#ifndef SCAN_REP
#define SCAN_REP 1
#endif
#define GRID_SYNC() do { for (int sr_ = 0; sr_ < SYNC_REP; ++sr_) xcd_barrier(xbar); } while (0)

__global__ void __launch_bounds__(NT, 2) hybrid_fwd(Args a_unused) {
    extern __shared__ __attribute__((aligned(16))) unsigned char lds_raw[];
    LAS unsigned char* lds = (LAS unsigned char*)lds_raw;
    cg::grid_group grid = cg::this_grid();
    const AS4 Args* ap = (const AS4 Args*)__builtin_amdgcn_kernarg_segment_ptr();
    { volatile LAS unsigned* st = (volatile LAS unsigned*)(lds + LDS_BYTES - 16);
      if (threadIdx.x < 4) st[threadIdx.x] = 0u;
      __syncthreads(); }
    const XcdBarrier xbar = xcd_barrier_post((unsigned*)(ap->ws + WS_BAR), (volatile LAS unsigned*)(lds + LDS_BYTES - 16));
    if (gridDim.x == 0x7fffffffu) grid.sync();

    { PH_BEGIN();
      p0_mods(IN(I_C), IN(I_CCTX), IN(I_ADAW), IN(I_ADAB), mod, lds, bid, G, tid, 0, 1);
      if (bid >= 96 || G < 192) convert_weight(IN(I_HWIN), D, 5 * D, Wmi, 0, lds, (G < 192 ? bid : bid - 96) * NWAVES + wave, (G < 192 ? G : G - 96) * NWAVES, wave, lane);
    }
    GRID_SYNC();
    { PH_BEGIN();
      p0_mods(IN(I_C), IN(I_CCTX), IN(I_ADAW), IN(I_ADAB), mod, lds, bid, G, tid, 1, 4);
      convert_weight(IN(I_HWOUT), D, D, Wmo, 0, lds, gw, NGW, wave, lane);
      NormJob J{}; J.xl_src = IN(I_X); J.xc_src = IN(I_CTX); J.src_f32 = 1; J.y = nullptr; J.h = H; J.nw_pre = IN(I_NORMW); J.sh = mod; J.sc = mod + D; J.rows = MALL;
      norm_phase(J, gw, NGW, lane); }
    GRID_SYNC();
#pragma unroll 1
    for (int l = 0; l < 4; ++l) {
        { PH_BEGIN();
          const bool is_h = (l & 1) == 0; const int rows_in = (l < 3) ? MALL : ML;
          const int N = is_h ? 5 * D : 3 * D;
          pg8::Gemm g{H, Wmi, rows_in, N, D}; pg8::StaticOrder So; So.init(rows_in, N, G, bid);
          pg8::EpiBf16 E{P, N};
          pg8::gemm_phase<pg8::EpiBf16, pg8::StaticOrder, true, true>(lds, g, So, E);
          if (l < 3) { const int fi = ((rows_in / 256) * (N / 256)) % G; const int nb = G - fi;
              if (bid >= fi) { const int gw2 = (bid - fi) * NWAVES + wave, NGW2 = nb * NWAVES;
                  convert_weight(IN(I_FWIN) + (size_t)l * D * 2 * FF, D, 2 * FF, Wf1, 1, lds, gw2, NGW2, wave, lane);
                  convert_weight(IN(I_FWOUT) + (size_t)l * FF * D, FF, D, Wf2, 0, lds, gw2, NGW2, wave, lane); } } }
        GRID_SYNC();
        if ((l & 1) == 0) {
            for (int rep_ = 0; rep_ < SCAN_REP; ++rep_) { PH_BEGIN(); scan_pass_a(P, IN(I_HLB), l >> 1, S, DEC, lds, bid, G, tid); }
            GRID_SYNC();
            { PH_BEGIN(); scan_pass_b(S, DEC, lds, bid, G, tid); }
            GRID_SYNC();
            for (int rep_ = 0; rep_ < SCAN_REP; ++rep_) { PH_BEGIN(); scan_pass_c(P, IN(I_HLB), IN(I_HGN) + (l >> 1) * HD, l >> 1, S, H, lds, bid, G, tid, (l < 2) ? 0 : 4); }
        } else {
            { PH_BEGIN(); conv_phase(P, IN(I_CW) + (size_t)(l >> 1) * 3 * D, H, (l < 2) ? MALL : ML, gt, GT); }
        }
        GRID_SYNC();
        { PH_BEGIN();
          pg8::Gemm g{H, Wmo, ML, D, D}; pg8::StaticOrder So; So.init(ML, D, G, bid);
          pg8::EpiBf16 E{Y1, D};
          pg8::gemm_phase<pg8::EpiBf16, pg8::StaticOrder, true, true>(lds, g, So, E);
          if (l < 2) ctx_gemm(H + (size_t)ML * D, Wmo, D, D, Y1 + (size_t)ML * D, lds, bid, G, tid); }
        GRID_SYNC();
        { PH_BEGIN();
          const int j = l >> 1; const bool is_h = (l & 1) == 0; const int rows_out = (l < 2) ? MALL : ML;
          const float* modl = mod + (size_t)l * 18 * D; const float* normw = IN(I_NORMW);
          NormJob J{}; J.xl_src = (l == 0) ? (const void*)IN(I_X) : (const void*)XB; J.xc_src = (l == 0) ? (const void*)IN(I_CTX) : (const void*)XC; J.src_f32 = (l == 0); J.xl_dst = (l == 3) ? XT : XB; J.xc_dst = XC;
          J.y = Y1; J.nw_post = normw + (l * 4 + 1) * D; J.gate = modl + 2 * D;
          J.h = H; J.nw_pre = normw + (l * 4 + 2) * D; J.sh = modl + 3 * D; J.sc = modl + 4 * D; J.rows = rows_out;
          norm_phase(J, gw, NGW, lane);
          (void)j; (void)is_h; }
        GRID_SYNC();
        { PH_BEGIN();
          const int rows_out = (l < 2) ? MALL : ML;
          pg8::Gemm g{H, Wf1, rows_out, 2 * FF, D}; pg8::StaticOrder So; So.init(rows_out, 2 * FF, G, bid);
          pg8::EpiSwiGLU E{A, FF};
          pg8::gemm_phase<pg8::EpiSwiGLU, pg8::StaticOrder, true, true>(lds, g, So, E);
          if (l < 3) { const int fi = ((rows_out / 256) * 22) % G; const int nb = G - fi;
              if (bid >= fi) { const int gw2 = (bid - fi) * NWAVES + wave, NGW2 = nb * NWAVES; const int j = l >> 1;
                  if ((l & 1) == 0) { convert_weight(IN(I_CWIN) + (size_t)j * D * 3 * D, D, 3 * D, Wmi, 0, lds, gw2, NGW2, wave, lane);
                                      convert_weight(IN(I_CWOUT) + (size_t)j * D * D, D, D, Wmo, 0, lds, gw2, NGW2, wave, lane); }
                  else { convert_weight(IN(I_HWIN) + (size_t)(j + 1) * D * 5 * D, D, 5 * D, Wmi, 0, lds, gw2, NGW2, wave, lane);
                         convert_weight(IN(I_HWOUT) + (size_t)(j + 1) * D * D, D, D, Wmo, 0, lds, gw2, NGW2, wave, lane); } } } }
        GRID_SYNC();
        { PH_BEGIN();
          pg8::Gemm g{A, Wf2, ML, D, FF}; pg8::StaticOrder So; So.init(ML, D, G, bid);
          pg8::EpiBf16 E{Y2, D};
          pg8::gemm_phase<pg8::EpiBf16, pg8::StaticOrder, true, true>(lds, g, So, E);
          if (l < 2) ctx_gemm(A + (size_t)ML * FF, Wf2, FF, D, Y2 + (size_t)ML * D, lds, bid, G, tid); }
        GRID_SYNC();
        { PH_BEGIN();
          const int rows_out = (l < 2) ? MALL : ML;
          const float* modl = mod + (size_t)l * 18 * D; const float* normw = IN(I_NORMW);
          NormJob J{}; J.xl_src = (l == 3) ? XT : XB; J.xc_src = XC; J.xl_dst = (l == 3) ? (void*)ap->out : (void*)XB; J.xc_dst = XC; J.dst_f32 = (l == 3);
          J.y = Y2; J.nw_post = normw + (l * 4 + 3) * D; J.gate = modl + 5 * D;
          if (l < 3) { const float* modn = mod + (size_t)(l + 1) * 18 * D; J.h = H; J.nw_pre = normw + ((l + 1) * 4) * D; J.sh = modn; J.sc = modn + D; }
          J.rows = rows_out;
          norm_phase(J, gw, NGW, lane);
          if (l == 2) { convert_weight(IN(I_FWIN) + (size_t)(l + 1) * D * 2 * FF, D, 2 * FF, Wf1, 1, lds, gw, NGW, wave, lane);
                       convert_weight(IN(I_FWOUT) + (size_t)(l + 1) * FF * D, FF, D, Wf2, 0, lds, gw, NGW, wave, lane); } }
        if (l < 3) GRID_SYNC();
    }
}

extern "C" void kernel_launch(void* const* d_in, const int* in_sizes, int n_in, void* d_out, int out_size, void* d_ws, size_t ws_size, hipStream_t stream) {
    static int grid = 0;
    if (grid == 0) {
        if (n_in != 16 || out_size != ML * D || ws_size < WS_END) { fprintf(stderr, "kernel_launch: unexpected shapes (n_in %d out %d ws %zu)\n", n_in, out_size, ws_size); grid = -1; return; }
        int dev = 0, cus = 0, per = 0;
        (void)hipGetDevice(&dev); (void)hipDeviceGetAttribute(&cus, hipDeviceAttributeMultiprocessorCount, dev);
        (void)hipFuncSetAttribute((const void*)hybrid_fwd, hipFuncAttributeMaxDynamicSharedMemorySize, LDS_BYTES);
        (void)hipOccupancyMaxActiveBlocksPerMultiprocessor(&per, (const void*)hybrid_fwd, NT, LDS_BYTES);
        (void)hipGetLastError();
        grid = cus > 0 ? cus : 256;
    }
    if (grid < 0) return;
    (void)hipMemsetAsync((char*)d_ws + WS_BAR, 0, 16384, stream);
    Args a{};
    for (int i = 0; i < 16; ++i) a.in[i] = (const float*)d_in[i];
    a.out = (float*)d_out; a.ws = (unsigned char*)d_ws;
    void* args[] = {&a};
    hipError_t e = hipLaunchCooperativeKernel((void*)hybrid_fwd, dim3(grid), dim3(NT), args, LDS_BYTES, stream);
    if (e != hipSuccess) fprintf(stderr, "cooperative launch failed: %s (grid %d)\n", hipGetErrorString(e), grid);
}
```

```cpp
#include <hip/hip_runtime.h>
#include <hip/hip_cooperative_groups.h>
#include <cstdio>
#include <cstdint>
namespace cg = cooperative_groups;
namespace pg8 {
#define PG8_LAS __attribute__((address_space(3)))
typedef unsigned short bf16_t;
typedef short bf16x8 __attribute__((ext_vector_type(8)));
typedef float f32x4 __attribute__((ext_vector_type(4)));
typedef unsigned u32x4 __attribute__((ext_vector_type(4)));
constexpr int BM = 256, BK = 64, HALF = 128, HTB = HALF * BK * 2  , STAGE_BYTES = 8 * HTB, NXCD = 8, WGM = 8;

__host__ __device__ __forceinline__ int lds_byte(int r, int c) { const int st = (r >> 4) * 2 + (c >> 5), rr = r & 15, cc = c & 31, ob = rr * 64 + cc * 2; return st * 1024 + (ob ^ (((ob >> 9) & 1) << 5)); }
__host__ __device__ __forceinline__ void stage_rc(int b, int& R, int& C) { const int st = b / 1024, sb = b % 1024, swz = sb ^ (((sb >> 9) & 1) << 5); R = (st >> 1) * 16 + swz / 64; C = (st & 1) * 32 + (swz % 64) / 2; }
__host__ __device__ __forceinline__ int perm32(int rho) { const int n = rho >> 4, i = rho & 15; return 8 * (i >> 2) + 4 * n + (i & 3); }

struct Unit { int pm, pn; };
struct Gemm { const bf16_t* A; const bf16_t* Bt; int M, N, K; };

struct StaticOrder {
    int nM, nN, nwg, G, c;
    __host__ __device__ void init(int M, int N, int G_, int c_) { nM = M / BM; nN = N / BM; nwg = nM * nN; G = G_; c = c_; }
    __host__ __device__ bool next(int i, Unit& u) const {
        const long L = (long)i * G + c; if (L >= nwg) return false;
        int wgid = (int)L; { const int q = nwg / NXCD, r = nwg % NXCD, xcd = wgid % NXCD, off = wgid / NXCD; wgid = (xcd < r ? xcd * (q + 1) : r * (q + 1) + (xcd - r) * q) + off; }
        const int nig = WGM * nN, gid = wgid / nig, fm = gid * WGM, gsz = (nM - fm) < WGM ? (nM - fm) : WGM;
        u.pm = fm + ((wgid % nig) % gsz); u.pn = (wgid % nig) / gsz; return true;
    }
    __device__ __forceinline__ void a_ready(const Unit&) const {}
    __device__ __forceinline__ void done(const Unit&) const {}
};

__device__ __forceinline__ unsigned cvt_pk_bf16(float lo, float hi) { unsigned r; asm volatile("v_cvt_pk_bf16_f32 %0, %1, %2" : "=v"(r) : "v"(lo), "v"(hi)); return r; }
typedef float f32x2 __attribute__((ext_vector_type(2)));
__device__ __forceinline__ void st16_wt(void* p, u32x4 v) { asm volatile("global_store_dwordx4 %0, %1, off sc1\n\ts_nop 1" :: "v"(p), "v"(v) : "memory"); }
typedef unsigned u32x2_ __attribute__((ext_vector_type(2)));
__device__ __forceinline__ void st8_wt(void* p, u32x2_ v) { asm volatile("global_store_dwordx2 %0, %1, off sc1\n\ts_nop 1" :: "v"(p), "v"(v) : "memory"); }

template <class Epi, class Sched, bool ALIGN_EPI = false, bool SP2 = false>
__device__ __forceinline__ void gemm_phase(PG8_LAS unsigned char* lds, const Gemm g, const Sched& S, const Epi& E) {
    const int tid = threadIdx.x, wid = __builtin_amdgcn_readfirstlane(tid >> 6), lane = tid & 63, wr = wid >> 2, wc = wid & 3, fr = lane & 15, fq = lane >> 4;
    const int K = g.K, nt = K / BK;
    unsigned voffA[2], voffB[2];
#pragma unroll
    for (int i = 0; i < 2; ++i) { int R, C; stage_rc(tid * 16 + i * 8192, R, C); const int Rb = Epi::PERM ? ((R & ~31) + perm32(R & 31)) : R;
        voffA[i] = (unsigned)(R * K + C) * 2u; voffB[i] = (unsigned)(Rb * K + C) * 2u; }
    const size_t kstep = (size_t)(BK * 2);
    const size_t hstep = (size_t)HALF * K * 2;
    const size_t tstep = 2 * hstep;
    const unsigned ldsw = (unsigned)wid * 1024u;
    const int aoff = lds_byte(wr * 64 + fr, fq * 8), boff = lds_byte(wc * 32 + fr, fq * 8);
#define PG8_SA(b, h) (((b) * 2 + (h)) * HTB)
#define PG8_SB(b, h) ((4 + (b) * 2 + (h)) * HTB)
#define PG8_STAGE(bufoff, gbase, voff) do { _Pragma("unroll") for (int _i = 0; _i < 2; ++_i) \
        __builtin_amdgcn_global_load_lds((const unsigned*)((const char*)(gbase) + (voff)[_i]), (PG8_LAS unsigned*)(lds + (bufoff) + ldsw + _i * 8192), 16, 0, 0); } while (0)
#define PG8_LDA(dst, b, h) do { _Pragma("unroll") for (int m = 0; m < 4; ++m) _Pragma("unroll") for (int k = 0; k < 2; ++k) dst[m][k] = *(const PG8_LAS bf16x8*)(lds + PG8_SA(b, h) + aoff + m * 2048 + k * 1024); } while (0)
#define PG8_LDB(dst, b, h) do { _Pragma("unroll") for (int n = 0; n < 2; ++n) _Pragma("unroll") for (int k = 0; k < 2; ++k) dst[n][k] = *(const PG8_LAS bf16x8*)(lds + PG8_SB(b, h) + boff + n * 2048 + k * 1024); } while (0)
#define PG8_MMA(ai, bj, At, Bt) do { __builtin_amdgcn_s_setprio(1); _Pragma("unroll") for (int m = 0; m < 4; ++m) _Pragma("unroll") for (int n = 0; n < 2; ++n) _Pragma("unroll") for (int k = 0; k < 2; ++k) \
        acc[ai][bj][m][n] = __builtin_amdgcn_mfma_f32_16x16x32_bf16(Bt[n][k], At[m][k], acc[ai][bj][m][n], 0, 0, 0); __builtin_amdgcn_s_setprio(0); } while (0)
#define PG8_WAIT_V(n) asm volatile("s_waitcnt vmcnt(" #n ")" ::: "memory")
#define PG8_WAIT_L(n) asm volatile("s_waitcnt lgkmcnt(" #n ")" ::: "memory")
#define PG8_BAR __builtin_amdgcn_s_barrier()
#define PG8_SCHED __builtin_amdgcn_sched_barrier(0)
    Unit cur, nxt; int ui = 0;
    if (!S.next(0, cur)) return;
    f32x4 acc[2][2][4][2];
#pragma unroll
    for (int a = 0; a < 2; ++a)
#pragma unroll
        for (int b = 0; b < 2; ++b)
#pragma unroll
            for (int m = 0; m < 4; ++m)
#pragma unroll
                for (int n = 0; n < 2; ++n) acc[a][b][m][n] = (f32x4){0.f, 0.f, 0.f, 0.f};
    bf16x8 At[4][2], B0[2][2], B1[2][2];
    const char* cA = (const char*)g.A + (size_t)cur.pm * tstep; const char* cB = (const char*)g.Bt + (size_t)cur.pn * tstep;
    S.a_ready(cur);
    if constexpr (SP2) {
        PG8_STAGE(PG8_SB(0, 0), cB, voffB); PG8_STAGE(PG8_SB(0, 1), cB + hstep, voffB); PG8_STAGE(PG8_SA(0, 0), cA, voffA); PG8_STAGE(PG8_SA(0, 1), cA + hstep, voffA);
        if (wr == 1) PG8_BAR;
        PG8_WAIT_V(2); PG8_BAR;
        PG8_STAGE(PG8_SB(1, 0), cB + kstep, voffB); PG8_STAGE(PG8_SA(1, 0), cA + kstep, voffA); PG8_STAGE(PG8_SB(1, 1), cB + hstep + kstep, voffB);
        PG8_WAIT_V(6); PG8_BAR;
    } else {
        PG8_STAGE(PG8_SB(0, 0), cB, voffB); PG8_STAGE(PG8_SA(0, 0), cA, voffA); PG8_STAGE(PG8_SB(0, 1), cB + hstep, voffB); PG8_STAGE(PG8_SA(0, 1), cA + hstep, voffA);
        if (wr == 1) PG8_BAR;
        PG8_WAIT_V(4); PG8_BAR;
        PG8_STAGE(PG8_SB(1, 0), cB + kstep, voffB); PG8_STAGE(PG8_SA(1, 0), cA + kstep, voffA); PG8_STAGE(PG8_SB(1, 1), cB + hstep + kstep, voffB);
        PG8_WAIT_V(6); PG8_BAR;
    }
    for (;;) {
        const bool has_next = S.next(ui + 1, nxt);
        const char* nA = has_next ? (const char*)g.A + (size_t)nxt.pm * tstep : cA; const char* nB = has_next ? (const char*)g.Bt + (size_t)nxt.pn * tstep : cB;
        for (int t = 0; t < nt; t += 2) {
            const bool last = (t == nt - 2);
            const char* a1 = cA + (size_t)(t + 1) * kstep;
            const char* a2 = last ? nA : cA + (size_t)(t + 2) * kstep; const char* b2 = last ? nB : cB + (size_t)(t + 2) * kstep;
            const char* a3 = a2 + kstep; const char* b3 = b2 + kstep;
            if (last && has_next) S.a_ready(nxt);
            if constexpr (SP2) {
            PG8_LDB(B0, 0, 0); PG8_LDB(B1, 0, 1); PG8_SCHED; PG8_LDA(At, 0, 0); PG8_STAGE(PG8_SA(1, 1), a1 + hstep, voffA);
            PG8_WAIT_V(8); PG8_WAIT_L(0); PG8_BAR; PG8_MMA(0, 0, At, B0); PG8_MMA(0, 1, At, B1); PG8_BAR; PG8_SCHED;
            PG8_LDA(At, 0, 1); PG8_STAGE(PG8_SB(0, 0), b2, voffB); PG8_STAGE(PG8_SB(0, 1), b2 + hstep, voffB); PG8_STAGE(PG8_SA(0, 0), a2, voffA);
            PG8_WAIT_V(8); PG8_WAIT_L(0); PG8_BAR; PG8_MMA(1, 0, At, B0); PG8_MMA(1, 1, At, B1); PG8_BAR; PG8_SCHED;
            PG8_LDB(B0, 1, 0); PG8_LDB(B1, 1, 1); PG8_SCHED; PG8_LDA(At, 1, 0); PG8_STAGE(PG8_SA(0, 1), a2 + hstep, voffA);
            PG8_WAIT_V(8); PG8_WAIT_L(0); PG8_BAR; PG8_MMA(0, 0, At, B0); PG8_MMA(0, 1, At, B1); PG8_BAR; PG8_SCHED;
            PG8_LDA(At, 1, 1); PG8_STAGE(PG8_SB(1, 0), b3, voffB); PG8_STAGE(PG8_SB(1, 1), b3 + hstep, voffB); PG8_STAGE(PG8_SA(1, 0), a3, voffA);
            PG8_WAIT_V(8); PG8_WAIT_L(0); PG8_BAR; PG8_MMA(1, 0, At, B0); PG8_MMA(1, 1, At, B1); PG8_BAR; PG8_SCHED;
            } else {
            PG8_LDB(B0, 0, 0); PG8_SCHED; PG8_LDA(At, 0, 0); PG8_STAGE(PG8_SA(1, 1), a1 + hstep, voffA);
            PG8_WAIT_L(8); PG8_BAR; PG8_WAIT_L(0); PG8_MMA(0, 0, At, B0); PG8_BAR; PG8_SCHED;
            PG8_LDB(B1, 0, 1); PG8_STAGE(PG8_SB(0, 0), b2, voffB);
            PG8_BAR; PG8_WAIT_L(0); PG8_MMA(0, 1, At, B1); PG8_BAR;
            PG8_LDA(At, 0, 1); PG8_STAGE(PG8_SA(0, 0), a2, voffA);
            PG8_BAR; PG8_WAIT_L(0); PG8_MMA(1, 0, At, B0); PG8_BAR; PG8_SCHED;
            PG8_STAGE(PG8_SB(0, 1), b2 + hstep, voffB);
            PG8_WAIT_V(6); PG8_BAR; PG8_MMA(1, 1, At, B1); PG8_BAR;
            PG8_LDB(B0, 1, 0); PG8_SCHED; PG8_LDA(At, 1, 0); PG8_STAGE(PG8_SA(0, 1), a2 + hstep, voffA);
            PG8_WAIT_L(8); PG8_BAR; PG8_WAIT_L(0); PG8_MMA(0, 0, At, B0); PG8_BAR; PG8_SCHED;
            PG8_LDB(B1, 1, 1); PG8_STAGE(PG8_SB(1, 0), b3, voffB);
            PG8_BAR; PG8_WAIT_L(0); PG8_MMA(0, 1, At, B1); PG8_BAR;
            PG8_LDA(At, 1, 1); PG8_STAGE(PG8_SA(1, 0), a3, voffA);
            PG8_BAR; PG8_WAIT_L(0); PG8_MMA(1, 0, At, B0); PG8_BAR; PG8_SCHED;
            PG8_STAGE(PG8_SB(1, 1), b3 + hstep, voffB);
            PG8_WAIT_V(6); PG8_BAR; PG8_MMA(1, 1, At, B1); PG8_BAR;
            }
        }
        if constexpr (ALIGN_EPI) { if (wr == 0) PG8_BAR; }
        if constexpr (!Epi::AFTER_DRAIN) { E(acc, cur, wr, wc, fr, fq); S.done(cur); }
        if (!has_next) break;
#pragma unroll
        for (int a = 0; a < 2; ++a)
#pragma unroll
            for (int b = 0; b < 2; ++b)
#pragma unroll
                for (int m = 0; m < 4; ++m)
#pragma unroll
                    for (int n = 0; n < 2; ++n) acc[a][b][m][n] = (f32x4){0.f, 0.f, 0.f, 0.f};
        cur = nxt; cA = nA; cB = nB; ++ui;
        if constexpr (ALIGN_EPI) { if (wr == 1) PG8_BAR; }
    }
    PG8_WAIT_V(0);
    if constexpr (!ALIGN_EPI) { if (wr == 0) PG8_BAR; }
    PG8_BAR;
    if constexpr (Epi::AFTER_DRAIN) { E.fused(acc, cur, wr, wc, fr, fq, lds, wid, lane); S.done(cur); }
#undef PG8_SA
#undef PG8_SB
#undef PG8_STAGE
#undef PG8_LDA
#undef PG8_LDB
#undef PG8_MMA
#undef PG8_WAIT_V
#undef PG8_WAIT_L
#undef PG8_BAR
#undef PG8_SCHED
}
}
namespace pg8 {
struct EpiBf16 {
    static constexpr bool PERM = true, AFTER_DRAIN = false;
    bf16_t* O; int ldc;
    __device__ __forceinline__ void operator()(const f32x4 (&acc)[2][2][4][2], const Unit& u, int wr, int wc, int fr, int fq) const {
        const int row0 = u.pm * BM + wr * 64 + fr; const int col0 = u.pn * BM + wc * 32 + 8 * fq;
#pragma unroll
        for (int ai = 0; ai < 2; ++ai)
#pragma unroll
            for (int m = 0; m < 4; ++m) { bf16_t* rowp = O + (size_t)(row0 + ai * HALF + m * 16) * ldc + col0;
#pragma unroll
                for (int bj = 0; bj < 2; ++bj) { const f32x4 v0 = acc[ai][bj][m][0], v1 = acc[ai][bj][m][1];
                    u32x4 w; w.x = cvt_pk_bf16(v0[0], v0[1]); w.y = cvt_pk_bf16(v0[2], v0[3]); w.z = cvt_pk_bf16(v1[0], v1[1]); w.w = cvt_pk_bf16(v1[2], v1[3]);
                    *(u32x4*)(rowp + bj * HALF) = w; } }
    }
};
struct EpiSwiGLU {
    static constexpr bool PERM = true, AFTER_DRAIN = false;
    bf16_t* O; int ldc;
    __device__ __forceinline__ void operator()(const f32x4 (&acc)[2][2][4][2], const Unit& u, int wr, int wc, int fr, int fq) const {
        const int row0 = u.pm * BM + wr * 64 + fr; const int col0 = u.pn * HALF + wc * 32 + 8 * fq;
#pragma unroll
        for (int ai = 0; ai < 2; ++ai)
#pragma unroll
            for (int m = 0; m < 4; ++m) { bf16_t* rowp = O + (size_t)(row0 + ai * HALF + m * 16) * ldc + col0;
                float r[8];
#pragma unroll
                for (int n = 0; n < 2; ++n)
#pragma unroll
                    for (int i = 0; i < 4; ++i) { const float g = acc[ai][0][m][n][i], up = acc[ai][1][m][n][i]; r[4 * n + i] = g * __builtin_amdgcn_rcpf(1.f + __expf(-g)) * up; }
                u32x4 w; w.x = cvt_pk_bf16(r[0], r[1]); w.y = cvt_pk_bf16(r[2], r[3]); w.z = cvt_pk_bf16(r[4], r[5]); w.w = cvt_pk_bf16(r[6], r[7]);
                *(u32x4*)rowp = w; }
    }
};
struct EpiF32 {
    static constexpr bool PERM = false, AFTER_DRAIN = false;
    float* O; int ldc;
    __device__ __forceinline__ void operator()(const f32x4 (&acc)[2][2][4][2], const Unit& u, int wr, int wc, int fr, int fq) const {
        const int row0 = u.pm * BM + wr * 64 + fr; const int col0 = u.pn * BM + wc * 32 + 4 * fq;
#pragma unroll
        for (int ai = 0; ai < 2; ++ai)
#pragma unroll
            for (int m = 0; m < 4; ++m) { float* rowp = O + (size_t)(row0 + ai * HALF + m * 16) * ldc + col0;
#pragma unroll
                for (int bj = 0; bj < 2; ++bj)
#pragma unroll
                    for (int n = 0; n < 2; ++n) *(f32x4*)(rowp + bj * HALF + n * 16) = acc[ai][bj][m][n]; }
    }
};
}
#define LAS __attribute__((address_space(3)))
typedef unsigned short bf16;
typedef float f32x4 __attribute__((ext_vector_type(4)));
typedef float f32x16 __attribute__((ext_vector_type(16)));
typedef float f32x2 __attribute__((ext_vector_type(2)));
typedef short bf16x8 __attribute__((ext_vector_type(8)));
typedef unsigned u32x4 __attribute__((ext_vector_type(4)));
typedef unsigned u32x2 __attribute__((ext_vector_type(2)));
constexpr int D = 1024, NB = 2, SEQ = 8192, CTXL = 256, ML = NB * SEQ, MC = NB * CTXL, MALL = ML + MC, FF = 2816, NH = 8, HD = 128;
constexpr int NCH = 132;
constexpr float EPS = 1e-6f, F_FLOOR = 1e-6f;
constexpr int NWAVES = 8, NT = 512;
constexpr int LDS_BYTES = 147456;
constexpr size_t MiB = 1u << 20;
constexpr size_t WS_BAR = 0;
constexpr size_t WS_MOD = 65536;
constexpr size_t CTL_ZERO_BYTES = 1 * MiB;
constexpr size_t WS_WMI = 1 * MiB, WS_WMO = 11 * MiB, WS_WF1 = 13 * MiB, WS_WF2 = 24 * MiB;
constexpr size_t WS_XC = 30 * MiB;
constexpr size_t WS_H = 32 * MiB;
constexpr size_t WS_P = 65 * MiB;
constexpr size_t WS_Y1 = WS_P, WS_A = WS_P, WS_Y2 = WS_P + 91 * MiB;
constexpr size_t WS_S = 230 * MiB;
constexpr size_t WS_DEC = 362 * MiB;
constexpr size_t WS_END = 367 * MiB;

__device__ __forceinline__ unsigned f2bf(float f) { unsigned u = __builtin_bit_cast(unsigned, f); return (u + 0x7fffu + ((u >> 16) & 1u)) >> 16; }
__device__ __forceinline__ unsigned pk2(float lo, float hi) { return f2bf(lo) | (f2bf(hi) << 16); }
__device__ __forceinline__ unsigned cvtpk(float lo, float hi) { unsigned r; asm("v_cvt_pk_bf16_f32 %0, %1, %2" : "=v"(r) : "v"(lo), "v"(hi)); return r; }
__device__ __forceinline__ float bf2f(unsigned short u) { return __builtin_bit_cast(float, (unsigned)u << 16); }
__device__ __forceinline__ float bflo(unsigned w) { return __builtin_bit_cast(float, w << 16); }
__device__ __forceinline__ float bfhi(unsigned w) { return __builtin_bit_cast(float, w & 0xffff0000u); }
__device__ __forceinline__ float dpp_xor1(float v) { return __builtin_bit_cast(float, __builtin_amdgcn_update_dpp(0, __builtin_bit_cast(int, v), 0xB1, 0xF, 0xF, true)); }
__device__ __forceinline__ float dpp_xor2(float v) { return __builtin_bit_cast(float, __builtin_amdgcn_update_dpp(0, __builtin_bit_cast(int, v), 0x4E, 0xF, 0xF, true)); }
__device__ __forceinline__ float dpp_hmir(float v) { return __builtin_bit_cast(float, __builtin_amdgcn_update_dpp(0, __builtin_bit_cast(int, v), 0x141, 0xF, 0xF, true)); }
__device__ __forceinline__ float dpp_rmir(float v) { return __builtin_bit_cast(float, __builtin_amdgcn_update_dpp(0, __builtin_bit_cast(int, v), 0x140, 0xF, 0xF, true)); }
__device__ __forceinline__ float wave_sum(float v) {
    v += dpp_xor1(v); v += dpp_xor2(v); v += dpp_hmir(v); v += dpp_rmir(v);
    const int iv = __builtin_bit_cast(int, v);
    const float r0 = __builtin_bit_cast(float, __builtin_amdgcn_readlane(iv, 0)), r1 = __builtin_bit_cast(float, __builtin_amdgcn_readlane(iv, 16));
    const float r2 = __builtin_bit_cast(float, __builtin_amdgcn_readlane(iv, 32)), r3 = __builtin_bit_cast(float, __builtin_amdgcn_readlane(iv, 48));
    return (r0 + r1) + (r2 + r3);
}
__device__ __forceinline__ float sigmoidf_(float z) { return __builtin_amdgcn_rcpf(1.f + __expf(-z)); }

#define MFMA32(a, b, c) __builtin_amdgcn_mfma_f32_32x32x16_bf16((a), (b), (c), 0, 0, 0)
__device__ __forceinline__ int crow(int i, int hh) { return (i & 3) + 8 * (i >> 2) + 4 * hh; }
struct Args { const float* in[16]; float* out; unsigned char* ws; };
enum { I_X = 0, I_C, I_CTX, I_CCTX, I_ADAW, I_ADAB, I_NORMW, I_HWIN, I_HWOUT, I_HGN, I_HLB, I_CWIN, I_CW, I_CWOUT, I_FWIN, I_FWOUT };

__device__ __forceinline__ void transpose_load(const float* W, int N, int item, int lane, float (&wv)[32]) {
    const int nblk = N / 32, kb = item / nblk, nb = item % nblk, k0 = 64 * kb, n0 = 32 * nb;
#pragma unroll
    for (int i = 0; i < 32; ++i) { const int kk = 2 * i + (lane >> 5); wv[i] = __builtin_nontemporal_load(W + (size_t)(k0 + kk) * N + n0 + (lane & 31)); }
}
__device__ __forceinline__ void transpose_store(const float (&wv)[32], int K, int N, bf16* WT, int mode, LAS float* scr, int item, int lane) {
    const int nblk = N / 32, kb = item / nblk, nb = item % nblk, k0 = 64 * kb, n0 = 32 * nb;
#pragma unroll
    for (int i = 0; i < 32; ++i) { const int kk = 2 * i + (lane >> 5); scr[kk * 33 + (lane & 31)] = wv[i]; }
    asm volatile("s_waitcnt lgkmcnt(0)" ::: "memory");
    int d0 = n0;
    if (mode == 1) { const int half = N / 2; d0 = (n0 < half) ? (n0 / 128) * 256 + (n0 % 128) : ((n0 - half) / 128) * 256 + 128 + ((n0 - half) % 128); }
    const int c = lane & 7;
#pragma unroll
    for (int j = 0; j < 4; ++j) { const int n = (lane >> 3) + 8 * j; const LAS float* s = scr + (8 * c) * 33 + n;
        u32x4 o; o.x = cvtpk(s[0 * 33], s[1 * 33]); o.y = cvtpk(s[2 * 33], s[3 * 33]); o.z = cvtpk(s[4 * 33], s[5 * 33]); o.w = cvtpk(s[6 * 33], s[7 * 33]);
        *(u32x4*)(WT + (size_t)(d0 + n) * K + k0 + 8 * c) = o; }
    asm volatile("s_waitcnt lgkmcnt(0)" ::: "memory");
}
__device__ __forceinline__ void convert_weight(const float* W, int K, int N, bf16* WT, int mode, LAS unsigned char* lds, int gw, int NGW, int wave, int lane) {
    LAS float* scr = (LAS float*)(lds + wave * 16384);
    const int nitems = (K / 64) * (N / 32);
    float wa[32], wb[32];
    int it = gw;
    if (it < nitems) transpose_load(W, N, it, lane, wa);
    for (; it < nitems; it += NGW) {
        const int nx = it + NGW;
        if (nx < nitems) transpose_load(W, N, nx, lane, wb);
        transpose_store(wa, K, N, WT, mode, scr, it, lane);
#pragma unroll
        for (int i = 0; i < 32; ++i) wa[i] = wb[i];
    }
}

__device__ __forceinline__ void p0_mods(const float* cin, const float* cctx, const float* adaw, const float* adab, float* mod, LAS unsigned char* lds, int bid, int G, int tid, int l_lo, int l_hi) {
    LAS float* sl = (LAS float*)lds;
    LAS float* red = (LAS float*)(lds + 12288);
    const int wave = tid >> 6, lane = tid & 63;
    for (int i = tid; i < 3 * D; i += NT) { const int mv = i / D, k = i % D; const float c = (mv < 2) ? cin[mv * D + k] : cctx[k]; sl[i] = c * sigmoidf_(c); }
    __syncthreads();
    for (int it = bid; it < (l_hi - l_lo) * 96; it += G) {
        const int l = l_lo + it / 96, n = (it % 96) * 64 + lane;
        const float* w = adaw + ((size_t)l * D + wave * 128) * (6 * D) + n;
        float a0 = 0.f, a1 = 0.f, a2 = 0.f;
#pragma unroll 32
        for (int k = 0; k < 128; ++k) { const float wv = __builtin_nontemporal_load(w + (size_t)k * (6 * D)); const int kk = wave * 128 + k; a0 += sl[kk] * wv; a1 += sl[D + kk] * wv; a2 += sl[2 * D + kk] * wv; }
        red[(wave * 3 + 0) * 64 + lane] = a0; red[(wave * 3 + 1) * 64 + lane] = a1; red[(wave * 3 + 2) * 64 + lane] = a2;
        __syncthreads();
        if (tid < 192) { const int mv = tid >> 6; float s = adab[l * 6 * D + n];
#pragma unroll
            for (int w8 = 0; w8 < 8; ++w8) s += red[(w8 * 3 + mv) * 64 + lane];
            mod[((size_t)l * 3 + mv) * 6 * D + n] = s; }
        __syncthreads();
    }
}

struct NormJob {
    const void* xl_src; const void* xc_src;
    void* xl_dst; void* xc_dst;
    const bf16* y;
    const float* nw_post; const float* gate;
    bf16* h; const float* nw_pre; const float* sh; const float* sc;
    int rows; int src_f32; int dst_f32; int pad;
};
#define NCB(q) (512 * ((q) >> 1) + 8 * lane + 4 * ((q) & 1))
__device__ __forceinline__ void norm_load_x(const NormJob& J, int row, int lane, f32x4 (&x)[4]) {
    if (J.src_f32) { const float* xs = row < ML ? (const float*)J.xl_src + (size_t)row * D : (const float*)J.xc_src + (size_t)(row - ML) * D;
#pragma unroll
        for (int q = 0; q < 4; ++q) x[q] = *(const f32x4*)(xs + NCB(q));
    } else { const bf16* xs = row < ML ? (const bf16*)J.xl_src + (size_t)row * D : (const bf16*)J.xc_src + (size_t)(row - ML) * D;
#pragma unroll
        for (int jj = 0; jj < 2; ++jj) { const u32x4 w = *(const u32x4*)(xs + 512 * jj + 8 * lane);
            x[2 * jj] = (f32x4){bflo(w.x), bfhi(w.x), bflo(w.y), bfhi(w.y)}; x[2 * jj + 1] = (f32x4){bflo(w.z), bfhi(w.z), bflo(w.w), bfhi(w.w)}; } }
}
__device__ __forceinline__ void norm_load_y(const NormJob& J, int row, int lane, u32x4 (&y)[2]) {
#pragma unroll
    for (int jj = 0; jj < 2; ++jj) y[jj] = *(const u32x4*)(J.y + (size_t)row * D + 512 * jj + 8 * lane);
}
struct NormParams { f32x4 nwp[4], g[4], nwq[4], sh[4], sc[4]; };
__device__ __forceinline__ void norm_load_mod(const NormJob& J, int mv, int lane, NormParams& Q) {
#pragma unroll
    for (int q = 0; q < 4; ++q) { const int c = NCB(q);
        if (J.y) Q.g[q] = *(const f32x4*)(J.gate + mv * 6 * D + c) * Q.nwp[q];
        if (J.h) { Q.sh[q] = *(const f32x4*)(J.sh + mv * 6 * D + c); Q.sc[q] = (1.f + *(const f32x4*)(J.sc + mv * 6 * D + c)) * Q.nwq[q]; } }
}
__device__ __forceinline__ void norm_row(const NormJob& J, int row, int lane, f32x4 (&x)[4], const u32x4 (&yb)[2], const NormParams& Q) {
    if (J.y) {
        f32x4 y[4]; float s = 0.f;
#pragma unroll
        for (int jj = 0; jj < 2; ++jj) { y[2 * jj] = (f32x4){bflo(yb[jj].x), bfhi(yb[jj].x), bflo(yb[jj].y), bfhi(yb[jj].y)}; y[2 * jj + 1] = (f32x4){bflo(yb[jj].z), bfhi(yb[jj].z), bflo(yb[jj].w), bfhi(yb[jj].w)}; }
#pragma unroll
        for (int q = 0; q < 4; ++q) s += (y[q].x * y[q].x + y[q].y * y[q].y) + (y[q].z * y[q].z + y[q].w * y[q].w);
        const float r = __builtin_amdgcn_rsqf(wave_sum(s) * (1.f / D) + EPS);
#pragma unroll
        for (int q = 0; q < 4; ++q) x[q] = x[q] + Q.g[q] * (y[q] * r);
        if (J.dst_f32) { float* xd = row < ML ? (float*)J.xl_dst + (size_t)row * D : (float*)J.xc_dst + (size_t)(row - ML) * D;
#pragma unroll
            for (int q = 0; q < 4; ++q) *(f32x4*)(xd + NCB(q)) = x[q];
        } else { bf16* xd = row < ML ? (bf16*)J.xl_dst + (size_t)row * D : (bf16*)J.xc_dst + (size_t)(row - ML) * D;
#pragma unroll
            for (int jj = 0; jj < 2; ++jj) { u32x4 w; w.x = cvtpk(x[2 * jj].x, x[2 * jj].y); w.y = cvtpk(x[2 * jj].z, x[2 * jj].w); w.z = cvtpk(x[2 * jj + 1].x, x[2 * jj + 1].y); w.w = cvtpk(x[2 * jj + 1].z, x[2 * jj + 1].w);
                *(u32x4*)(xd + 512 * jj + 8 * lane) = w;
                x[2 * jj] = (f32x4){bflo(w.x), bfhi(w.x), bflo(w.y), bfhi(w.y)}; x[2 * jj + 1] = (f32x4){bflo(w.z), bfhi(w.z), bflo(w.w), bfhi(w.w)}; } }
    }
    if (J.h) {
        float s = 0.f;
#pragma unroll
        for (int q = 0; q < 4; ++q) s += (x[q].x * x[q].x + x[q].y * x[q].y) + (x[q].z * x[q].z + x[q].w * x[q].w);
        const float r = __builtin_amdgcn_rsqf(wave_sum(s) * (1.f / D) + EPS);
        f32x4 o[4];
#pragma unroll
        for (int q = 0; q < 4; ++q) o[q] = (x[q] * r) * Q.sc[q] + Q.sh[q];
#pragma unroll
        for (int jj = 0; jj < 2; ++jj) { u32x4 w; w.x = cvtpk(o[2 * jj].x, o[2 * jj].y); w.y = cvtpk(o[2 * jj].z, o[2 * jj].w); w.z = cvtpk(o[2 * jj + 1].x, o[2 * jj + 1].y); w.w = cvtpk(o[2 * jj + 1].z, o[2 * jj + 1].w);
            *(u32x4*)(J.h + (size_t)row * D + 512 * jj + 8 * lane) = w; }
    }
}
__device__ __forceinline__ void norm_phase(const NormJob& J, int gw, int NGW, int lane) {
    const int base = J.rows / NGW, rem = J.rows % NGW;
    const int r0 = gw * base + (gw < rem ? gw : rem), r1 = r0 + base + (gw < rem ? 1 : 0);
    if (r0 >= r1) return;
    NormParams Q;
#pragma unroll
    for (int q = 0; q < 4; ++q) { const int c = NCB(q); Q.nwp[q] = J.y ? *(const f32x4*)(J.nw_post + c) : (f32x4){0.f, 0.f, 0.f, 0.f}; Q.nwq[q] = J.h ? *(const f32x4*)(J.nw_pre + c) : (f32x4){0.f, 0.f, 0.f, 0.f};
        Q.g[q] = Q.sh[q] = Q.sc[q] = (f32x4){0.f, 0.f, 0.f, 0.f}; }
    int cur_mv = -1;
    f32x4 xa[4], xb[4]; u32x4 ya[2], yb[2];
    const bool hy = J.y != nullptr;
    int row = r0;
    norm_load_x(J, row, lane, xa); if (hy) norm_load_y(J, row, lane, ya);
    if (row + 1 < r1) { norm_load_x(J, row + 1, lane, xb); if (hy) norm_load_y(J, row + 1, lane, yb); }
    for (; row < r1; ++row) {
        f32x4 x0[4]; u32x4 y0[2];
#pragma unroll
        for (int q = 0; q < 4; ++q) { x0[q] = xa[q]; xa[q] = xb[q]; }
#pragma unroll
        for (int jj = 0; jj < 2; ++jj) { y0[jj] = ya[jj]; ya[jj] = yb[jj]; }
        if (row + 2 < r1) { norm_load_x(J, row + 2, lane, xb); if (hy) norm_load_y(J, row + 2, lane, yb); }
        { const int mv = row < ML ? (row >> 13) : 2; if (mv != cur_mv) { norm_load_mod(J, mv, lane, Q); cur_mv = mv; } }
        norm_row(J, row, lane, x0, y0, Q);
    }
}
#undef NCB

__device__ __forceinline__ void ctx_gemm(const bf16* A, const bf16* Bt, int K, int N, bf16* Y, LAS unsigned char* lds, int bid, int G, int tid) {
    constexpr int CS = 528;
    constexpr int OFF_A = 0, OFF_B = 32 * CS, OFF_RED = 96 * CS;
    static_assert(OFF_RED + 65536 <= LDS_BYTES - 16, "ctx_gemm LDS map");
    const int wave = tid >> 6, lane = tid & 63, r = lane & 31, hh = lane >> 5;
    LAS float* red = (LAS float*)(lds + OFF_RED);
    const int ncb = N / 64, nch = K / 256;
    const int srow = tid >> 5, spc = tid & 31;
    for (int t = bid; t < 16 * ncb; t += G) {
        const int rb = t / ncb, cb = t % ncb;
        const bf16* ag = A + (size_t)(32 * rb + srow) * K + 8 * spc;
        const bf16* bg = Bt + (size_t)(64 * cb + srow) * K + 8 * spc;
        u32x4 pa[2], pb[4];
#pragma unroll
        for (int i = 0; i < 2; ++i) pa[i] = *(const u32x4*)(ag + (size_t)(16 * i) * K);
#pragma unroll
        for (int i = 0; i < 4; ++i) pb[i] = *(const u32x4*)(bg + (size_t)(16 * i) * K);
        f32x16 acc0, acc1;
#pragma unroll
        for (int i = 0; i < 16; ++i) { acc0[i] = 0.f; acc1[i] = 0.f; }
        for (int c = 0; c < nch; ++c) {
            __syncthreads();
#pragma unroll
            for (int i = 0; i < 2; ++i) *(LAS u32x4*)(lds + OFF_A + (srow + 16 * i) * CS + 16 * spc) = pa[i];
#pragma unroll
            for (int i = 0; i < 4; ++i) *(LAS u32x4*)(lds + OFF_B + (srow + 16 * i) * CS + 16 * spc) = pb[i];
            if (c + 1 < nch) {
#pragma unroll
                for (int i = 0; i < 2; ++i) pa[i] = *(const u32x4*)(ag + (size_t)(16 * i) * K + 256 * (c + 1));
#pragma unroll
                for (int i = 0; i < 4; ++i) pb[i] = *(const u32x4*)(bg + (size_t)(16 * i) * K + 256 * (c + 1));
            }
            __syncthreads();
#pragma unroll
            for (int s = 0; s < 2; ++s) { const int ko = (32 * wave + 16 * s + 8 * hh) * 2;
                const bf16x8 a = *(const LAS bf16x8*)(lds + OFF_A + r * CS + ko);
                const bf16x8 b0 = *(const LAS bf16x8*)(lds + OFF_B + r * CS + ko), b1 = *(const LAS bf16x8*)(lds + OFF_B + (32 + r) * CS + ko);
                acc0 = MFMA32(a, b0, acc0); acc1 = MFMA32(a, b1, acc1); }
        }
#pragma unroll
        for (int i = 0; i < 16; ++i) { red[(wave * 32 + i) * 64 + lane] = acc0[i]; red[(wave * 32 + 16 + i) * 64 + lane] = acc1[i]; }
        __syncthreads();
#pragma unroll
        for (int q = 0; q < 4; ++q) { const int ri = wave + 8 * q;
            float s = 0.f;
#pragma unroll
            for (int w8 = 0; w8 < 8; ++w8) s += red[(w8 * 32 + ri) * 64 + lane];
            const int ti = ri >> 4, i = ri & 15; const int row = 32 * rb + crow(i, hh), col = 64 * cb + 32 * ti + r;
            Y[(size_t)row * N + col] = (bf16)f2bf(s); }
    }
    __syncthreads();
}

__device__ __forceinline__ void conv_phase(const bf16* P, const float* cw, bf16* R, int rows, int gt, int GT) {
    const int total = (rows / 8) * 128;
    for (int it = gt; it < total; it += GT) {
        const int row0 = (it >> 7) * 8, c0 = (it & 127) * 8;
        bool hl, hr;
        if (row0 < ML) { const int t = row0 & 63; hl = t != 0; hr = t != 56; } else { const int t = (row0 - ML) & 255; hl = t != 0; hr = t != 248; }
        const bf16* p = P + (size_t)row0 * 3072 + c0;
        u32x4 gc[10], xi[10], gb[8];
#pragma unroll
        for (int i = 0; i < 10; ++i) { const bool ok = (i == 0) ? hl : (i == 9 ? hr : true);
            if (ok) { gc[i] = *(const u32x4*)(p + (size_t)(i - 1) * 3072 + 1024); xi[i] = *(const u32x4*)(p + (size_t)(i - 1) * 3072 + 2048); }
            else { gc[i] = (u32x4){0, 0, 0, 0}; xi[i] = (u32x4){0, 0, 0, 0}; } }
#pragma unroll
        for (int i = 0; i < 8; ++i) gb[i] = *(const u32x4*)(p + (size_t)i * 3072);
        float w0[8], w1[8], w2[8];
#pragma unroll
        for (int q = 0; q < 2; ++q) { const f32x4 a0 = *(const f32x4*)(cw + c0 + 4 * q), a1 = *(const f32x4*)(cw + D + c0 + 4 * q), a2 = *(const f32x4*)(cw + 2 * D + c0 + 4 * q);
#pragma unroll
            for (int i = 0; i < 4; ++i) { w0[4 * q + i] = a0[i]; w1[4 * q + i] = a1[i]; w2[4 * q + i] = a2[i]; } }
        float up[8], uc[8], un[8];
#pragma unroll
        for (int c = 0; c < 4; ++c) { up[2 * c] = bflo(gc[0][c]) * bflo(xi[0][c]); up[2 * c + 1] = bfhi(gc[0][c]) * bfhi(xi[0][c]); uc[2 * c] = bflo(gc[1][c]) * bflo(xi[1][c]); uc[2 * c + 1] = bfhi(gc[1][c]) * bfhi(xi[1][c]); }
#pragma unroll
        for (int i = 0; i < 8; ++i) {
#pragma unroll
            for (int c = 0; c < 4; ++c) { un[2 * c] = bflo(gc[i + 2][c]) * bflo(xi[i + 2][c]); un[2 * c + 1] = bfhi(gc[i + 2][c]) * bfhi(xi[i + 2][c]); }
            u32x4 o;
#pragma unroll
            for (int c = 0; c < 4; ++c) { const float yl = up[2 * c] * w0[2 * c] + uc[2 * c] * w1[2 * c] + un[2 * c] * w2[2 * c], yh = up[2 * c + 1] * w0[2 * c + 1] + uc[2 * c + 1] * w1[2 * c + 1] + un[2 * c + 1] * w2[2 * c + 1];
                o[c] = cvtpk(bflo(gb[i][c]) * yl, bfhi(gb[i][c]) * yh); }
            *(u32x4*)(R + (size_t)(row0 + i) * D + c0) = o;
#pragma unroll
            for (int c = 0; c < 8; ++c) { up[c] = uc[c]; uc[c] = un[c]; }
        }
    }
}

__device__ __forceinline__ int unit_row0(int b, int cid) { return cid < 4 ? ML + b * CTXL + cid * 64 : b * SEQ + (cid - 4) * 64; }
__device__ __forceinline__ size_t slot_index(int b, int h, int dir, int cid) { return (size_t)(((b * NH + h) * 2 + dir) * NCH + cid); }
__device__ __forceinline__ float lower_bound_of(const float* hlb, int j, int d) { return j == 0 ? 0.f : sigmoidf_(hlb[D + d] - hlb[d]); }

constexpr float LOG2E = 1.4426950408889634f;
#define GATE1(zv, lbv, omlv, lfo, kko) do { const float e_ = __builtin_amdgcn_exp2f(-(zv) * LOG2E); const float sg_ = __builtin_amdgcn_rcpf(1.f + e_); \
    lfo = __builtin_amdgcn_logf(fmaxf(__builtin_fmaf(omlv, sg_, lbv), F_FLOOR)); kko = __builtin_fmaf(-(omlv), sg_, omlv); } while (0)
#define GATE2(zw_, lb2_, om2_, lfo, kko) do { const f32x2 a_ = (f32x2){bflo(zw_), bfhi(zw_)} * (-LOG2E); \
    const f32x2 s_ = (f32x2){__builtin_amdgcn_exp2f(a_.x), __builtin_amdgcn_exp2f(a_.y)} + 1.f; \
    const f32x2 sg_ = (f32x2){__builtin_amdgcn_rcpf(s_.x), __builtin_amdgcn_rcpf(s_.y)}; \
    const f32x2 f_ = om2_ * sg_ + lb2_; \
    lfo = (f32x2){__builtin_amdgcn_logf(fmaxf(f_.x, F_FLOOR)), __builtin_amdgcn_logf(fmaxf(f_.y, F_FLOOR))}; kko = om2_ - om2_ * sg_; } while (0)

__device__ void scan_pass_a(const bf16* P, const float* hlb, int j, bf16* S, float* DEC, LAS unsigned char* lds, int bid, int G, int tid) {
    constexpr int KE_STRIDE = 72 * 2, BUF = 3 * 128 * KE_STRIDE;
    constexpr int OFF_TOT = 2 * BUF;
    static_assert(OFF_TOT + 4096 <= LDS_BYTES - 16, "pass A LDS map");
    const int wave = tid >> 6, lane = tid & 63, r = lane & 31, hh = lane >> 5;
    const int dir = wave >> 2, qt = wave & 3, kp = lane;
    LAS float* tot = (LAS float*)(lds + OFF_TOT);
    const int NU = NB * NH * NCH;
    int par = 0;
    unsigned zw[16]; u32x4 v0, v1;
    f32x2 hla = (f32x2){0.f, 0.f}, hlb2 = (f32x2){0.f, 0.f};
    int u = bid;
    if (u < NU) { const int b = u / (NH * NCH), h = (u / NCH) % NH, cid = u % NCH; const int row0 = unit_row0(b, cid);
        const bf16* zp = P + (size_t)(row0 + 16 * qt) * 5120 + 2048 + dir * 1024 + h * HD + 2 * kp;
#pragma unroll
        for (int s = 0; s < 16; ++s) zw[s] = *(const unsigned*)(zp + (size_t)s * 5120);
        const bf16* vp = P + (size_t)(row0 + lane) * 5120 + 1024 + h * HD + 16 * wave; v0 = *(const u32x4*)vp; v1 = *(const u32x4*)(vp + 8);  if (j != 0) { hla = *(const f32x2*)(hlb + h * HD + 2 * kp); hlb2 = *(const f32x2*)(hlb + D + h * HD + 2 * kp); } }
    for (; u < NU; u += G, par ^= 1) {
        const int b = u / (NH * NCH), h = (u / NCH) % NH, cid = u % NCH;
        LAS unsigned char* buf = lds + par * BUF;
        { LAS bf16* vt = (LAS bf16*)(buf + 2 * 128 * KE_STRIDE) + (16 * wave) * 72 + lane;
#pragma unroll
          for (int i = 0; i < 4; ++i) { vt[(2 * i) * 72] = (bf16)(v0[i] & 0xffffu); vt[(2 * i + 1) * 72] = (bf16)(v0[i] >> 16); vt[(8 + 2 * i) * 72] = (bf16)(v1[i] & 0xffffu); vt[(8 + 2 * i + 1) * 72] = (bf16)(v1[i] >> 16); } }
        const int ch = h * HD + 2 * kp;
        const float lb0 = j == 0 ? 0.f : sigmoidf_(hlb2.x - hla.x), lb1 = j == 0 ? 0.f : sigmoidf_(hlb2.y - hla.y), om0 = 1.f - lb0, om1 = 1.f - lb1; (void)ch;
        float lf0[16], lf1[16], k0[16], k1[16];
        float t0 = 0.f, t1 = 0.f;
#pragma unroll
        for (int s = 0; s < 16; ++s) { GATE1(bflo(zw[s]), lb0, om0, lf0[s], k0[s]); GATE1(bfhi(zw[s]), lb1, om1, lf1[s], k1[s]); t0 += lf0[s]; t1 += lf1[s]; }
        *(LAS f32x2*)(tot + (dir * 4 + qt) * 128 + 2 * kp) = (f32x2){t0, t1};
        { const int un = u + G; if (un < NU) { const int bn = un / (NH * NCH), hn = (un / NCH) % NH, cn = un % NCH; const int rown = unit_row0(bn, cn);
            const bf16* zp = P + (size_t)(rown + 16 * qt) * 5120 + 2048 + dir * 1024 + hn * HD + 2 * kp;
#pragma unroll
            for (int s = 0; s < 16; ++s) zw[s] = *(const unsigned*)(zp + (size_t)s * 5120);
            const bf16* vp = P + (size_t)(rown + lane) * 5120 + 1024 + hn * HD + 16 * wave; v0 = *(const u32x4*)vp; v1 = *(const u32x4*)(vp + 8);  if (j != 0) { hla = *(const f32x2*)(hlb + hn * HD + 2 * kp); hlb2 = *(const f32x2*)(hlb + D + hn * HD + 2 * kp); } } }
        __syncthreads();
        float T0 = 0.f, T1 = 0.f, c0 = 0.f, c1 = 0.f;
#pragma unroll
        for (int q = 0; q < 4; ++q) { const f32x2 tq = *(const LAS f32x2*)(tot + (dir * 4 + q) * 128 + 2 * kp); T0 += tq.x; T1 += tq.y;
            const bool before = dir == 0 ? (q < qt) : (q > qt); if (before) { c0 += tq.x; c1 += tq.y; } }
        { unsigned w0[8], w1[8];
          if (dir == 0) {
#pragma unroll
              for (int s = 0; s < 16; ++s) { c0 += lf0[s]; c1 += lf1[s]; k0[s] *= __builtin_amdgcn_exp2f(T0 - c0); k1[s] *= __builtin_amdgcn_exp2f(T1 - c1); }
          } else {
#pragma unroll
              for (int s = 15; s >= 0; --s) { c0 += lf0[s]; c1 += lf1[s]; k0[s] *= __builtin_amdgcn_exp2f(T0 - c0); k1[s] *= __builtin_amdgcn_exp2f(T1 - c1); }
          }
#pragma unroll
          for (int i = 0; i < 8; ++i) { w0[i] = cvtpk(k0[2 * i], k0[2 * i + 1]); w1[i] = cvtpk(k1[2 * i], k1[2 * i + 1]); }
          LAS u32x4* p0 = (LAS u32x4*)(buf + (dir * 128 + 2 * kp) * KE_STRIDE + 32 * qt);
          LAS u32x4* p1 = (LAS u32x4*)(buf + (dir * 128 + 2 * kp + 1) * KE_STRIDE + 32 * qt);
          p0[0] = (u32x4){w0[0], w0[1], w0[2], w0[3]}; p0[1] = (u32x4){w0[4], w0[5], w0[6], w0[7]};
          p1[0] = (u32x4){w1[0], w1[1], w1[2], w1[3]}; p1[1] = (u32x4){w1[4], w1[5], w1[6], w1[7]}; }
        if (qt == 0) *(f32x2*)(DEC + slot_index(b, h, dir, cid) * 128 + 2 * kp) = (f32x2){__builtin_amdgcn_exp2f(T0), __builtin_amdgcn_exp2f(T1)};
        __syncthreads();
        { const int wd = wave >> 2, kt = wave & 3;
          bf16x8 af[4];
#pragma unroll
          for (int st = 0; st < 4; ++st) af[st] = *(const LAS bf16x8*)(buf + (wd * 128 + 32 * kt + r) * KE_STRIDE + (16 * st + 8 * hh) * 2);
          bf16* sp = S + slot_index(b, h, wd, cid) * (128 * 128);
#pragma unroll
          for (int vt_ = 0; vt_ < 4; ++vt_) {
              f32x16 acc;
#pragma unroll
              for (int i = 0; i < 16; ++i) acc[i] = 0.f;
#pragma unroll
              for (int st = 0; st < 4; ++st) { const bf16x8 bfr = *(const LAS bf16x8*)(buf + 2 * 128 * KE_STRIDE + (32 * vt_ + r) * KE_STRIDE + (16 * st + 8 * hh) * 2); acc = MFMA32(af[st], bfr, acc); }
#pragma unroll
              for (int g = 0; g < 4; ++g) { u32x2 w; w.x = pk2(acc[4 * g], acc[4 * g + 1]); w.y = pk2(acc[4 * g + 2], acc[4 * g + 3]);
                  *(u32x2*)(sp + ((vt_ * 8 + 2 * kt + (g >> 1)) * 64 + (g & 1) * 32 + r) * 8 + 4 * hh) = w; }
          } }
    }
}

__device__ void scan_pass_b(bf16* S, const float* DEC, LAS unsigned char* lds, int bid, int G, int tid) {
  LAS float* dl = (LAS float*)lds;
  for (int blk = bid; blk < NB * NH * 2 * 8; blk += G) {
    const int seq = blk >> 3, e4 = (blk & 7) * 512 + tid;
    const int dir = seq & 1;
    const int e = 4 * e4, k4 = 16 * ((e >> 9) & 7) + 8 * ((e >> 8) & 1) + (e & 7);
    __syncthreads();
    { const f32x4* src = (const f32x4*)(DEC + (size_t)seq * NCH * 128);
      for (int i = tid; i < NCH * 32; i += NT) ((LAS f32x4*)dl)[i] = src[i]; }
    __syncthreads();
    bf16* base = S + (size_t)seq * NCH * 16384 + e;
    float s0 = 0.f, s1 = 0.f, s2 = 0.f, s3 = 0.f;
    constexpr int GP = 22;
    u32x2 Lc[GP];
#pragma unroll
    for (int q = 0; q < GP; ++q) { const int cid = dir == 0 ? q : (q < 4 ? 3 - q : 135 - q); Lc[q] = *(const u32x2*)(base + (size_t)cid * 16384); }
    for (int p = 0; p < NCH; p += GP) {
        u32x2 Ln[GP];
        if (p + GP < NCH) {
#pragma unroll
            for (int q = 0; q < GP; ++q) { const int pp = p + GP + q; const int cid = dir == 0 ? pp : (pp < 4 ? 3 - pp : 135 - pp); Ln[q] = *(const u32x2*)(base + (size_t)cid * 16384); }
        }
#pragma unroll
        for (int q = 0; q < GP; ++q) { const int pp = p + q; const int cid = dir == 0 ? pp : (pp < 4 ? 3 - pp : 135 - pp);
            u32x2 w; w.x = cvtpk(s0, s1); w.y = cvtpk(s2, s3);
            *(u32x2*)(base + (size_t)cid * 16384) = w;
            const f32x4 dq = *(const LAS f32x4*)(dl + cid * 128 + k4);
            s0 = dq.x * s0 + bflo(Lc[q].x); s1 = dq.y * s1 + bfhi(Lc[q].x); s2 = dq.z * s2 + bflo(Lc[q].y); s3 = dq.w * s3 + bfhi(Lc[q].y); }
#pragma unroll
        for (int q = 0; q < GP; ++q) Lc[q] = Ln[q];
    }
  }
}

__device__ void scan_pass_c(const bf16* P, const float* hlb, const float* gnorm, int j, const bf16* S, bf16* R, LAS unsigned char* lds, int bid, int G, int tid, int cid_lo) {
    constexpr int QS = 136 * 2, PS = 72 * 2;
    constexpr int OFF_QI = 0, OFF_QS = 2 * 64 * QS, OFF_KS = 4 * 64 * QS, OFF_VT = 6 * 64 * QS, OFF_P = OFF_VT + 128 * PS, OFF_TOT = OFF_P + 2 * 64 * PS;
    constexpr int OFF_O = OFF_QS;
    static_assert(OFF_TOT + 4096 <= LDS_BYTES - 16 && OFF_O + 64 * 132 * 4 <= OFF_KS, "pass C LDS map");
    const int wave = tid >> 6, lane = tid & 63, r = lane & 31, hh = lane >> 5;
    const int dir = wave >> 2, qt = wave & 3, kp = lane;
    LAS float* tot = (LAS float*)(lds + OFF_TOT);
    const int ncid = NCH - cid_lo, NU = NB * NH * ncid;
    unsigned zw[16], qw[16]; u32x4 v0, v1;
    float gnv[16];
#pragma unroll
    for (int i = 0; i < 16; ++i) gnv[i] = gnorm[(tid & 7) * 16 + i];
    f32x2 hla = (f32x2){0.f, 0.f}, hlb2 = (f32x2){0.f, 0.f};
    int u = bid;
    if (u < NU) { const int b = u / (NH * ncid), h = (u / ncid) % NH, cid = cid_lo + u % ncid; const int row0 = unit_row0(b, cid);
        const bf16* zp = P + (size_t)(row0 + 16 * qt) * 5120 + 2048 + dir * 1024 + h * HD + 2 * kp;
        const bf16* qp = P + (size_t)(row0 + 16 * qt) * 5120 + h * HD + 2 * kp;
#pragma unroll
        for (int s = 0; s < 16; ++s) { zw[s] = *(const unsigned*)(zp + (size_t)s * 5120); qw[s] = *(const unsigned*)(qp + (size_t)s * 5120); }
        const bf16* vp = P + (size_t)(row0 + lane) * 5120 + 1024 + h * HD + 16 * wave; v0 = *(const u32x4*)vp; v1 = *(const u32x4*)(vp + 8);  if (j != 0) { hla = *(const f32x2*)(hlb + h * HD + 2 * kp); hlb2 = *(const f32x2*)(hlb + D + h * HD + 2 * kp); } }
    for (; u < NU; u += G) {
        const int b = u / (NH * ncid), h = (u / ncid) % NH, cid = cid_lo + u % ncid;
        const int row0 = unit_row0(b, cid);
        { LAS bf16* vt = (LAS bf16*)(lds + OFF_VT) + (16 * wave) * 72 + lane;
#pragma unroll
          for (int i = 0; i < 4; ++i) { vt[(2 * i) * 72] = (bf16)(v0[i] & 0xffffu); vt[(2 * i + 1) * 72] = (bf16)(v0[i] >> 16); vt[(8 + 2 * i) * 72] = (bf16)(v1[i] & 0xffffu); vt[(8 + 2 * i + 1) * 72] = (bf16)(v1[i] >> 16); } }
        const int ch = h * HD + 2 * kp;
        const float lb0 = j == 0 ? 0.f : sigmoidf_(hlb2.x - hla.x), lb1 = j == 0 ? 0.f : sigmoidf_(hlb2.y - hla.y), om0 = 1.f - lb0, om1 = 1.f - lb1; (void)ch;
        const f32x2 lb2 = (f32x2){lb0, lb1}, om2 = (f32x2){om0, om1};
        f32x2 lf[16], kk[16];
        f32x2 t2 = (f32x2){0.f, 0.f};
#pragma unroll
        for (int s = 0; s < 16; ++s) { GATE2(zw[s], lb2, om2, lf[s], kk[s]); t2 += lf[s]; }
        *(LAS f32x2*)(tot + (dir * 4 + qt) * 128 + 2 * kp) = t2;
        __syncthreads();
        f32x2 c2 = (f32x2){0.f, 0.f}, m2 = (f32x2){0.f, 0.f};
#pragma unroll
        for (int q = 0; q < 4; ++q) { const f32x2 tq = *(const LAS f32x2*)(tot + (dir * 4 + q) * 128 + 2 * kp);
            const bool before = dir == 0 ? (q < qt) : (q > qt); if (before) c2 += tq;
            const bool inref = dir == 0 ? (q < 2) : (q >= 2); if (inref) m2 += tq; }
        {
            LAS unsigned* qi = (LAS unsigned*)(lds + OFF_QI + dir * 64 * QS + (16 * qt) * QS) + kp;
            LAS unsigned* qs = (LAS unsigned*)(lds + OFF_QS + dir * 64 * QS + (16 * qt) * QS) + kp;
            LAS unsigned* ks = (LAS unsigned*)(lds + OFF_KS + dir * 64 * QS + (16 * qt) * QS) + kp;
            const float qscale = 0.08838834764831845f;
            const bool fast = __builtin_amdgcn_ballot_w64(!(m2.x > -100.f && m2.y > -100.f)) == 0ull;
            const f32x2 em2 = (f32x2){__builtin_amdgcn_exp2f(m2.x), __builtin_amdgcn_exp2f(m2.y)};
#define PC_STEP(s, FAST) do { c2 += lf[s]; \
                const f32x2 q2 = (f32x2){bflo(qw[s]), bfhi(qw[s])} * qscale; \
                const f32x2 d2 = c2 - m2; \
                const f32x2 e2 = (f32x2){__builtin_amdgcn_exp2f(__builtin_amdgcn_fmed3f(d2.x, -115.f, 115.f)), __builtin_amdgcn_exp2f(__builtin_amdgcn_fmed3f(d2.y, -115.f, 115.f))}; \
                const f32x2 E2 = (FAST) ? e2 * em2 : (f32x2){__builtin_amdgcn_exp2f(c2.x), __builtin_amdgcn_exp2f(c2.y)}; \
                const f32x2 qi2 = q2 * E2, qs2 = q2 * e2, ks2 = kk[s] * (f32x2){__builtin_amdgcn_rcpf(e2.x), __builtin_amdgcn_rcpf(e2.y)}; \
                qi[(s) * (QS / 4)] = cvtpk(qi2.x, qi2.y); qs[(s) * (QS / 4)] = cvtpk(qs2.x, qs2.y); ks[(s) * (QS / 4)] = cvtpk(ks2.x, ks2.y); } while (0)
            if (fast) {
                if (dir == 0) {
#pragma unroll
                    for (int s = 0; s < 16; ++s) PC_STEP(s, true);
                } else {
#pragma unroll
                    for (int s = 15; s >= 0; --s) PC_STEP(s, true);
                }
            } else {
                if (dir == 0) {
#pragma unroll
                    for (int s = 0; s < 16; ++s) PC_STEP(s, false);
                } else {
#pragma unroll
                    for (int s = 15; s >= 0; --s) PC_STEP(s, false);
                }
            }
#undef PC_STEP
        }
        const int rt = wave & 1, ct = wave >> 1;
        bf16x8 sb[2][8];
#pragma unroll
        for (int d = 0; d < 2; ++d) { const bf16* sp = S + slot_index(b, h, d, cid) * (128 * 128) + (size_t)(ct * 8 * 64 + lane) * 8;
#pragma unroll
            for (int st = 0; st < 8; ++st) sb[d][st] = *(const bf16x8*)(sp + st * 512); }
        const bf16* gp_ = P + (size_t)(row0 + (tid >> 3)) * 5120 + 4096 + h * HD + (tid & 7) * 16;
        const u32x4 g0 = *(const u32x4*)gp_, g1 = *(const u32x4*)(gp_ + 8);
        __syncthreads();
        { const int wd = wave >> 2, tt = (wave >> 1) & 1, st_ = wave & 1;
          f32x16 acc;
#pragma unroll
          for (int i = 0; i < 16; ++i) acc[i] = 0.f;
          const bool dead = (wd == 0) ? (st_ > tt) : (st_ < tt);
          if (!dead) {
#pragma unroll
              for (int st = 0; st < 8; ++st) {
                  const bf16x8 af = *(const LAS bf16x8*)(lds + OFF_QS + wd * 64 * QS + (32 * tt + r) * QS + (16 * st + 8 * hh) * 2);
                  const bf16x8 bfr = *(const LAS bf16x8*)(lds + OFF_KS + wd * 64 * QS + (32 * st_ + r) * QS + (16 * st + 8 * hh) * 2);
                  acc = MFMA32(af, bfr, acc);
              }
          }
          LAS bf16* pp = (LAS bf16*)(lds + OFF_P + wd * 64 * PS);
#pragma unroll
          for (int i = 0; i < 16; ++i) { const int tq = 32 * tt + crow(i, hh), sq = 32 * st_ + r; const bool keep = (wd == 0) ? (sq <= tq) : (sq >= tq);
              pp[tq * 72 + sq] = (bf16)(cvtpk(keep ? acc[i] : 0.f, 0.f) & 0xffffu); }
        }
        __syncthreads();
        { const int un = u + G; if (un < NU) { const int bn = un / (NH * ncid), hn = (un / ncid) % NH, cn = cid_lo + un % ncid; const int rown = unit_row0(bn, cn);
            const bf16* zp = P + (size_t)(rown + 16 * qt) * 5120 + 2048 + dir * 1024 + hn * HD + 2 * kp;
            const bf16* qp = P + (size_t)(rown + 16 * qt) * 5120 + hn * HD + 2 * kp;
#pragma unroll
            for (int s = 0; s < 16; ++s) { zw[s] = *(const unsigned*)(zp + (size_t)s * 5120); qw[s] = *(const unsigned*)(qp + (size_t)s * 5120); }
            const bf16* vp = P + (size_t)(rown + lane) * 5120 + 1024 + hn * HD + 16 * wave; v0 = *(const u32x4*)vp; v1 = *(const u32x4*)(vp + 8);  if (j != 0) { hla = *(const f32x2*)(hlb + hn * HD + 2 * kp); hlb2 = *(const f32x2*)(hlb + D + hn * HD + 2 * kp); } } }
        f32x16 o;
#pragma unroll
        for (int i = 0; i < 16; ++i) o[i] = 0.f;
#pragma unroll
        for (int d = 0; d < 2; ++d) {
#pragma unroll
            for (int st = 0; st < 8; ++st) { const bf16x8 af = *(const LAS bf16x8*)(lds + OFF_QI + d * 64 * QS + (32 * rt + r) * QS + (16 * st + 8 * hh) * 2); o = MFMA32(af, sb[d][st], o); }
#pragma unroll
            for (int st = 0; st < 4; ++st) { const bf16x8 af = *(const LAS bf16x8*)(lds + OFF_P + d * 64 * PS + (32 * rt + r) * PS + (16 * st + 8 * hh) * 2);
                const bf16x8 bfr = *(const LAS bf16x8*)(lds + OFF_VT + (32 * ct + r) * PS + (16 * st + 8 * hh) * 2); o = MFMA32(af, bfr, o); }
        }
        { LAS float* os = (LAS float*)(lds + OFF_O);
#pragma unroll
          for (int i = 0; i < 16; ++i) os[(32 * rt + crow(i, hh)) * 132 + 32 * ct + r] = o[i]; }
        __syncthreads();
        { const int tq = tid >> 3, c0_ = (tid & 7) * 16;
          const LAS float* os = (const LAS float*)(lds + OFF_O) + tq * 132 + c0_;
          float v[16]; float ss = 0.f;
#pragma unroll
          for (int q = 0; q < 4; ++q) { const f32x4 x = *(const LAS f32x4*)(os + 4 * q); v[4 * q] = x.x; v[4 * q + 1] = x.y; v[4 * q + 2] = x.z; v[4 * q + 3] = x.w; ss += (x.x * x.x + x.y * x.y) + (x.z * x.z + x.w * x.w); }
          ss += dpp_xor1(ss); ss += dpp_xor2(ss); ss += dpp_hmir(ss);
          const float rs = __builtin_amdgcn_rsqf(ss * (1.f / HD) + EPS);
          float gv[16];
#pragma unroll
          for (int i = 0; i < 4; ++i) { gv[2 * i] = bflo(g0[i]); gv[2 * i + 1] = bfhi(g0[i]); gv[8 + 2 * i] = bflo(g1[i]); gv[8 + 2 * i + 1] = bfhi(g1[i]); }
          float ov[16];
#pragma unroll
          for (int i = 0; i < 16; ++i) { const float gg = gv[i]; ov[i] = v[i] * rs * gnv[i] * (gg * sigmoidf_(gg)); }
          u32x4 w0, w1;
#pragma unroll
          for (int i = 0; i < 4; ++i) { w0[i] = cvtpk(ov[2 * i], ov[2 * i + 1]); w1[i] = cvtpk(ov[8 + 2 * i], ov[8 + 2 * i + 1]); }
          bf16* rp = R + (size_t)(row0 + tq) * D + h * HD + c0_;
          *(u32x4*)rp = w0; *(u32x4*)(rp + 8) = w1; }
    }
}
typedef __attribute__((address_space(1))) unsigned gu32;
#define XB_TMO      128
#define XB_XCNT(j)  (256  + 64 * (j))
#define XB_XSUB(j)  (1280 + 64 * (j))
#define XB_XGEN(j)  (2304 + 64 * (j))
#define XB_TOP      3328
#define XB_TOPGEN   3392
#define XCD_BAR_WORDS 3456
#define XB_SPIN_CAP (1u << 18)

__device__ __forceinline__ unsigned xb_ld(unsigned* p)              { return __hip_atomic_load(p, __ATOMIC_RELAXED, __HIP_MEMORY_SCOPE_AGENT); }
__device__ __forceinline__ unsigned xb_add(unsigned* p, unsigned v) { return __hip_atomic_fetch_add(p, v, __ATOMIC_RELAXED, __HIP_MEMORY_SCOPE_AGENT); }
__device__ __forceinline__ unsigned xb_xcc_id() { return (unsigned)__builtin_amdgcn_s_getreg((3 << 11) | 20) & 0xFu; }
#define XB_SPIN(cond, bar) do { unsigned _sp = 0; while (cond) { __builtin_amdgcn_s_sleep(1); \
    if ((++_sp & 255u) == 0u) { if (xb_ld(&(bar)[XB_TMO])) break; if (_sp > XB_SPIN_CAP) { atomicAdd(&(bar)[XB_TMO], 1u); break; } } } } while (0)

struct XcdBarrier {
    unsigned* bar; unsigned x;
    volatile LAS unsigned* st;
};

__device__ __forceinline__ XcdBarrier xcd_barrier_post(unsigned* bar, volatile LAS unsigned* st) {
    XcdBarrier b; b.bar = bar; b.x = xb_xcc_id(); b.st = st;
    if (threadIdx.x == 0) (void)xb_add(&bar[XB_XCNT(b.x)], 1u);
    return b;
}
__device__ __forceinline__ void xcd_barrier_complete(unsigned* bar, unsigned x, unsigned& nloc, unsigned& nx) {
    const unsigned G = gridDim.x * gridDim.y * gridDim.z;
    unsigned sum, cnt, mine, sp = 0u;
    for (;;) {
        sum = 0u; cnt = 0u; mine = 0u;
#pragma unroll
        for (unsigned j = 0; j < 16; ++j) { const unsigned c = xb_ld(&bar[XB_XCNT(j)]); sum += c; cnt += (c > 0u) ? 1u : 0u; mine = (j == x) ? c : mine; }
        if (sum == G) break;
        __builtin_amdgcn_s_sleep(1);
        if ((++sp & 255u) == 0u) { if (xb_ld(&bar[XB_TMO])) break; if (sp > XB_SPIN_CAP) { atomicAdd(&bar[XB_TMO], 1u); break; } }
    }
    nloc = mine > 0u ? mine : 1u; nx = cnt > 0u ? cnt : 1u;
}

__device__ __forceinline__ void xcd_barrier(const XcdBarrier& b) {
    asm volatile("s_waitcnt vmcnt(0)" ::: "memory");
    __syncthreads();
    if (threadIdx.x == 0) {
        unsigned* bar = b.bar;
        __builtin_amdgcn_s_waitcnt(0);
        unsigned nloc = b.st[0], nx = b.st[1];
        if (nloc == 0u) { xcd_barrier_complete(bar, b.x, nloc, nx); b.st[0] = nloc; b.st[1] = nx; }
        const unsigned old = xb_add(&bar[XB_XSUB(b.x)], 1u);
        const unsigned gen = old / nloc;
        if (old + 1u == (gen + 1u) * nloc) {
            __builtin_amdgcn_fence(__ATOMIC_RELEASE, "agent");
            asm volatile("s_waitcnt vmcnt(0)" ::: "memory");
            const unsigned og = xb_add(&bar[XB_TOP], 1u);
            const unsigned tg = og / nx;
            if (og + 1u == (tg + 1u) * nx) xb_add(&bar[XB_TOPGEN], 1u);
            else XB_SPIN(xb_ld(&bar[XB_TOPGEN]) == tg, bar);
            __builtin_amdgcn_fence(__ATOMIC_ACQUIRE, "agent");
            xb_add(&bar[XB_XGEN(b.x)], 1u);
            asm volatile("s_waitcnt vmcnt(0)" ::: "memory");
        } else {
            XB_SPIN(xb_ld(&bar[XB_XGEN(b.x)]) == gen, bar);
            __builtin_amdgcn_fence(__ATOMIC_ACQUIRE, "agent");
            asm volatile("s_waitcnt vmcnt(0)" ::: "memory");
        }
    }
    __syncthreads();
}

#define AS4 __attribute__((address_space(4)))
#define PH_BEGIN() \
    asm volatile("" : "+s"(ap) :: "memory"); \
    int tid_ = threadIdx.x; asm volatile("" : "+v"(tid_)); const int tid = tid_, lane = tid & 63, wave = __builtin_amdgcn_readfirstlane(tid >> 6); \
    int bid_ = blockIdx.x; asm volatile("" : "+s"(bid_)); const int G = gridDim.x, bid = bid_; \
    const int gw = bid * NWAVES + wave, NGW = G * NWAVES, gt = bid * NT + tid, GT = G * NT; \
    unsigned char* ws = ap->ws; float* mod = (float*)(ws + WS_MOD); \
    bf16* Wmi = (bf16*)(ws + WS_WMI); bf16* Wmo = (bf16*)(ws + WS_WMO); bf16* Wf1 = (bf16*)(ws + WS_WF1); bf16* Wf2 = (bf16*)(ws + WS_WF2); \
    bf16* XC = (bf16*)(ws + WS_XC); bf16* XB = (bf16*)((unsigned char*)ap->out + 32 * MiB); bf16* XT = (bf16*)(ws + WS_P + 125 * MiB); (void)XB; (void)XT; bf16* H = (bf16*)(ws + WS_H); bf16* P = (bf16*)(ws + WS_P); \
    bf16* Y1 = (bf16*)(ws + WS_Y1); bf16* A = (bf16*)(ws + WS_A); bf16* Y2 = (bf16*)(ws + WS_Y2); \
    bf16* S = (bf16*)(ws + WS_S); float* DEC = (float*)(ws + WS_DEC); \
    (void)lane; (void)gw; (void)NGW; (void)gt; (void)GT; (void)mod; (void)Wmi; (void)Wmo; (void)Wf1; (void)Wf2; (void)XC; (void)H; (void)P; (void)Y1; (void)A; (void)Y2; (void)S; (void)DEC; (void)bid; (void)G;
#define IN(i) (ap->in[i])
#ifndef GEMM_REP
#define GEMM_REP 1
#endif
#ifndef SYNC_REP
#define SYNC_REP 1
#endif
#ifndef SCAN_REP
#define SCAN_REP 1
#endif
#define GRID_SYNC() do { for (int sr_ = 0; sr_ < SYNC_REP; ++sr_) xcd_barrier(xbar); } while (0)

__global__ void __launch_bounds__(NT, 2) hybrid_fwd(Args a_unused) {
    extern __shared__ __attribute__((aligned(16))) unsigned char lds_raw[];
    LAS unsigned char* lds = (LAS unsigned char*)lds_raw;
    cg::grid_group grid = cg::this_grid();
    const AS4 Args* ap = (const AS4 Args*)__builtin_amdgcn_kernarg_segment_ptr();
    { volatile LAS unsigned* st = (volatile LAS unsigned*)(lds + LDS_BYTES - 16);
      if (threadIdx.x < 4) st[threadIdx.x] = 0u;
      __syncthreads(); }
    const XcdBarrier xbar = xcd_barrier_post((unsigned*)(ap->ws + WS_BAR), (volatile LAS unsigned*)(lds + LDS_BYTES - 16));
    if (gridDim.x == 0x7fffffffu) grid.sync();

    { PH_BEGIN();
      p0_mods(IN(I_C), IN(I_CCTX), IN(I_ADAW), IN(I_ADAB), mod, lds, bid, G, tid, 0, 1);
      if (bid >= 96 || G < 192) convert_weight(IN(I_HWIN), D, 5 * D, Wmi, 0, lds, (G < 192 ? bid : bid - 96) * NWAVES + wave, (G < 192 ? G : G - 96) * NWAVES, wave, lane);
    }
    GRID_SYNC();
    { PH_BEGIN();
      p0_mods(IN(I_C), IN(I_CCTX), IN(I_ADAW), IN(I_ADAB), mod, lds, bid, G, tid, 1, 4);
      convert_weight(IN(I_HWOUT), D, D, Wmo, 0, lds, gw, NGW, wave, lane);
      NormJob J{}; J.xl_src = IN(I_X); J.xc_src = IN(I_CTX); J.src_f32 = 1; J.y = nullptr; J.h = H; J.nw_pre = IN(I_NORMW); J.sh = mod; J.sc = mod + D; J.rows = MALL;
      norm_phase(J, gw, NGW, lane); }
    GRID_SYNC();
#pragma unroll 1
    for (int l = 0; l < 4; ++l) {
        { PH_BEGIN();
          const bool is_h = (l & 1) == 0; const int rows_in = (l < 3) ? MALL : ML;
          const int N = is_h ? 5 * D : 3 * D;
          pg8::Gemm g{H, Wmi, rows_in, N, D}; pg8::StaticOrder So; So.init(rows_in, N, G, bid);
          pg8::EpiBf16 E{P, N};
          pg8::gemm_phase<pg8::EpiBf16, pg8::StaticOrder, true, true>(lds, g, So, E);
          if (l < 3) { const int fi = ((rows_in / 256) * (N / 256)) % G; const int nb = G - fi;
              if (bid >= fi) { const int gw2 = (bid - fi) * NWAVES + wave, NGW2 = nb * NWAVES;
                  convert_weight(IN(I_FWIN) + (size_t)l * D * 2 * FF, D, 2 * FF, Wf1, 1, lds, gw2, NGW2, wave, lane);
                  convert_weight(IN(I_FWOUT) + (size_t)l * FF * D, FF, D, Wf2, 0, lds, gw2, NGW2, wave, lane); } } }
        GRID_SYNC();
        if ((l & 1) == 0) {
            for (int rep_ = 0; rep_ < SCAN_REP; ++rep_) { PH_BEGIN(); scan_pass_a(P, IN(I_HLB), l >> 1, S, DEC, lds, bid, G, tid); }
            GRID_SYNC();
            { PH_BEGIN(); scan_pass_b(S, DEC, lds, bid, G, tid); }
            GRID_SYNC();
            for (int rep_ = 0; rep_ < SCAN_REP; ++rep_) { PH_BEGIN(); scan_pass_c(P, IN(I_HLB), IN(I_HGN) + (l >> 1) * HD, l >> 1, S, H, lds, bid, G, tid, (l < 2) ? 0 : 4); }
        } else {
            { PH_BEGIN(); conv_phase(P, IN(I_CW) + (size_t)(l >> 1) * 3 * D, H, (l < 2) ? MALL : ML, gt, GT); }
        }
        GRID_SYNC();
        { PH_BEGIN();
          pg8::Gemm g{H, Wmo, ML, D, D}; pg8::StaticOrder So; So.init(ML, D, G, bid);
          pg8::EpiBf16 E{Y1, D};
          pg8::gemm_phase<pg8::EpiBf16, pg8::StaticOrder, true, true>(lds, g, So, E);
          if (l < 2) ctx_gemm(H + (size_t)ML * D, Wmo, D, D, Y1 + (size_t)ML * D, lds, bid, G, tid); }
        GRID_SYNC();
        { PH_BEGIN();
          const int j = l >> 1; const bool is_h = (l & 1) == 0; const int rows_out = (l < 2) ? MALL : ML;
          const float* modl = mod + (size_t)l * 18 * D; const float* normw = IN(I_NORMW);
          NormJob J{}; J.xl_src = (l == 0) ? (const void*)IN(I_X) : (const void*)XB; J.xc_src = (l == 0) ? (const void*)IN(I_CTX) : (const void*)XC; J.src_f32 = (l == 0); J.xl_dst = (l == 3) ? XT : XB; J.xc_dst = XC;
          J.y = Y1; J.nw_post = normw + (l * 4 + 1) * D; J.gate = modl + 2 * D;
          J.h = H; J.nw_pre = normw + (l * 4 + 2) * D; J.sh = modl + 3 * D; J.sc = modl + 4 * D; J.rows = rows_out;
          norm_phase(J, gw, NGW, lane);
          (void)j; (void)is_h; }
        GRID_SYNC();
        { PH_BEGIN();
          const int rows_out = (l < 2) ? MALL : ML;
          pg8::Gemm g{H, Wf1, rows_out, 2 * FF, D}; pg8::StaticOrder So; So.init(rows_out, 2 * FF, G, bid);
          pg8::EpiSwiGLU E{A, FF};
          pg8::gemm_phase<pg8::EpiSwiGLU, pg8::StaticOrder, true, true>(lds, g, So, E);
          if (l < 3) { const int fi = ((rows_out / 256) * 22) % G; const int nb = G - fi;
              if (bid >= fi) { const int gw2 = (bid - fi) * NWAVES + wave, NGW2 = nb * NWAVES; const int j = l >> 1;
                  if ((l & 1) == 0) { convert_weight(IN(I_CWIN) + (size_t)j * D * 3 * D, D, 3 * D, Wmi, 0, lds, gw2, NGW2, wave, lane);
                                      convert_weight(IN(I_CWOUT) + (size_t)j * D * D, D, D, Wmo, 0, lds, gw2, NGW2, wave, lane); }
                  else { convert_weight(IN(I_HWIN) + (size_t)(j + 1) * D * 5 * D, D, 5 * D, Wmi, 0, lds, gw2, NGW2, wave, lane);
                         convert_weight(IN(I_HWOUT) + (size_t)(j + 1) * D * D, D, D, Wmo, 0, lds, gw2, NGW2, wave, lane); } } } }
        GRID_SYNC();
        { PH_BEGIN();
          pg8::Gemm g{A, Wf2, ML, D, FF}; pg8::StaticOrder So; So.init(ML, D, G, bid);
          pg8::EpiBf16 E{Y2, D};
          pg8::gemm_phase<pg8::EpiBf16, pg8::StaticOrder, true, true>(lds, g, So, E);
          if (l < 2) ctx_gemm(A + (size_t)ML * FF, Wf2, FF, D, Y2 + (size_t)ML * D, lds, bid, G, tid); }
        GRID_SYNC();
        { PH_BEGIN();
          const int rows_out = (l < 2) ? MALL : ML;
          const float* modl = mod + (size_t)l * 18 * D; const float* normw = IN(I_NORMW);
          NormJob J{}; J.xl_src = (l == 3) ? XT : XB; J.xc_src = XC; J.xl_dst = (l == 3) ? (void*)ap->out : (void*)XB; J.xc_dst = XC; J.dst_f32 = (l == 3);
          J.y = Y2; J.nw_post = normw + (l * 4 + 3) * D; J.gate = modl + 5 * D;
          if (l < 3) { const float* modn = mod + (size_t)(l + 1) * 18 * D; J.h = H; J.nw_pre = normw + ((l + 1) * 4) * D; J.sh = modn; J.sc = modn + D; }
          J.rows = rows_out;
          norm_phase(J, gw, NGW, lane);
          if (l == 2) { convert_weight(IN(I_FWIN) + (size_t)(l + 1) * D * 2 * FF, D, 2 * FF, Wf1, 1, lds, gw, NGW, wave, lane);
                       convert_weight(IN(I_FWOUT) + (size_t)(l + 1) * FF * D, FF, D, Wf2, 0, lds, gw, NGW, wave, lane); } }
        if (l < 3) GRID_SYNC();
    }
}

extern "C" void kernel_launch(void* const* d_in, const int* in_sizes, int n_in, void* d_out, int out_size, void* d_ws, size_t ws_size, hipStream_t stream) {
    static int grid = 0;
    if (grid == 0) {
        if (n_in != 16 || out_size != ML * D || ws_size < WS_END) { fprintf(stderr, "kernel_launch: unexpected shapes (n_in %d out %d ws %zu)\n", n_in, out_size, ws_size); grid = -1; return; }
        int dev = 0, cus = 0, per = 0;
        (void)hipGetDevice(&dev); (void)hipDeviceGetAttribute(&cus, hipDeviceAttributeMultiprocessorCount, dev);
        (void)hipFuncSetAttribute((const void*)hybrid_fwd, hipFuncAttributeMaxDynamicSharedMemorySize, LDS_BYTES);
        (void)hipOccupancyMaxActiveBlocksPerMultiprocessor(&per, (const void*)hybrid_fwd, NT, LDS_BYTES);
        (void)hipGetLastError();
        grid = cus > 0 ? cus : 256;
    }
    if (grid < 0) return;
    (void)hipMemsetAsync((char*)d_ws + WS_BAR, 0, 16384, stream);
    Args a{};
    for (int i = 0; i < 16; ++i) a.in[i] = (const float*)d_in[i];
    a.out = (float*)d_out; a.ws = (unsigned char*)d_ws;
    void* args[] = {&a};
    hipError_t e = hipLaunchCooperativeKernel((void*)hybrid_fwd, dim3(grid), dim3(NT), args, LDS_BYTES, stream);
    if (e != hipSuccess) fprintf(stderr, "cooperative launch failed: %s (grid %d)\n", hipGetErrorString(e), grid);
}
```
